# Optimizing an MI355X kernel written in HIP

```python
import math
import jax, jax.numpy as jnp
from jax import lax
import numpy as np

D_MODEL = 4096
BATCH = 4
SEQ = 4096
DEPTH = 4

CHUNK = 64
N_MIXERS = 2
SSD_EXPAND = 2
SSD_D_INNER = SSD_EXPAND * D_MODEL
SSD_HEADDIM = 64
SSD_HEADS = SSD_D_INNER // SSD_HEADDIM
SSD_GROUPS = 8
SSD_HEADS_PER_GROUP = SSD_HEADS // SSD_GROUPS
SSD_STATE = 128
SSD_CONV = 4
SSD_CONV_DIM = SSD_D_INNER + 2 * SSD_GROUPS * SSD_STATE
SSD_PROJ = SSD_D_INNER + SSD_CONV_DIM + SSD_HEADS
SC_WIDTH = 3
PEER_HEADS = 8
PEER_NKEYS = 128
PEER_EXPERTS = PEER_NKEYS * PEER_NKEYS
PEER_TOPK = 16
PEER_HALF_DIM = 128
PEER_QUERY_DIM = 2 * PEER_HALF_DIM
PEER_TOKEN_BLOCK = 128
LN_EPS = 1e-5
RMS_EPS = 1e-5
DEEPNORM_ALPHA = (2 * DEPTH) ** 0.25
DEEPNORM_BETA = (8 * DEPTH) ** -0.25

kernel_name = "hybrid_ssd_shortconv_peer_deepnorm"


def layer_norm(h, g, b):
    hf = h.astype(jnp.float32)
    mu = jnp.mean(hf, axis=-1, keepdims=True)
    var = jnp.mean(jnp.square(hf - mu), axis=-1, keepdims=True)
    out = (hf - mu) * lax.rsqrt(var + LN_EPS) * g.astype(jnp.float32) + b.astype(jnp.float32)
    return out.astype(h.dtype)


def causal_dwconv(h, w):
    k_width = w.shape[0]
    s = h.shape[1]
    hp = jnp.pad(h, ((0, 0), (k_width - 1, 0), (0, 0)))
    out = hp[:, 0:s] * w[0]
    for k in range(1, k_width):
        out = out + hp[:, k:k + s] * w[k]
    return out


def ssd_chunked_scan(xs, dt, a, bm, cm):
    bn, s, g, j, p = xs.shape
    n = bm.shape[-1]
    nc = s // CHUNK
    f32 = jnp.float32
    xdt = (xs.astype(f32) * dt[..., None]).reshape(bn, nc, CHUNK, g, j, p)
    bc = bm.astype(f32).reshape(bn, nc, CHUNK, g, n)
    cc = cm.astype(f32).reshape(bn, nc, CHUNK, g, n)
    acs = jnp.cumsum((dt * a).reshape(bn, nc, CHUNK, g, j), axis=2)
    acs_t = jnp.moveaxis(acs, 2, -1)
    seg = acs_t[..., :, None] - acs_t[..., None, :]
    causal = jnp.tril(jnp.ones((CHUNK, CHUNK), dtype=bool))
    decay_ls = jnp.exp(jnp.where(causal, seg, -jnp.inf))
    cb = jnp.einsum('bclgn,bcsgn->bcgls', cc, bc)
    w_ls = cb[:, :, :, None] * decay_ls
    y_diag = jnp.einsum('bcgjls,bcsgjp->bclgjp', w_ls, xdt)

    def step(state, inp):
        b_k, c_k, xdt_k, acs_k = inp
        y_off = jnp.einsum('blgn,bgjpn->blgjp', c_k, state) * jnp.exp(acs_k)[..., None]
        to_end = jnp.exp(acs_k[:, -1:] - acs_k)
        new_state = state * jnp.exp(acs_k[:, -1])[..., None, None] + jnp.einsum(
            'blgn,blgjp->bgjpn', b_k, xdt_k * to_end[..., None])
        return new_state, y_off

    init = jnp.zeros((bn, g, j, p, n), f32)
    swap = lambda t: jnp.moveaxis(t, 1, 0)
    _, y_off = lax.scan(step, init, (swap(bc), swap(cc), swap(xdt), swap(acs)))
    y = y_diag + jnp.moveaxis(y_off, 0, 1)
    return y.reshape(bn, s, g, j, p)


def ssd_mixer(x, in_proj, conv_w, conv_b, dt_bias, a_log, d_skip, norm_w, out_proj):
    bn, s, _ = x.shape
    f32 = jnp.float32
    zxbcdt = x @ in_proj
    z = zxbcdt[..., :SSD_D_INNER]
    xbc = zxbcdt[..., SSD_D_INNER:SSD_D_INNER + SSD_CONV_DIM]
    dt_raw = zxbcdt[..., SSD_D_INNER + SSD_CONV_DIM:]
    xbc = jax.nn.silu(causal_dwconv(xbc, conv_w) + conv_b)
    gn = SSD_GROUPS * SSD_STATE
    xs = xbc[..., :SSD_D_INNER].reshape(bn, s, SSD_GROUPS, SSD_HEADS_PER_GROUP, SSD_HEADDIM)
    bm = xbc[..., SSD_D_INNER:SSD_D_INNER + gn].reshape(bn, s, SSD_GROUPS, SSD_STATE)
    cm = xbc[..., SSD_D_INNER + gn:].reshape(bn, s, SSD_GROUPS, SSD_STATE)
    dt = jax.nn.softplus(dt_raw.astype(f32) + dt_bias.astype(f32))
    dt = dt.reshape(bn, s, SSD_GROUPS, SSD_HEADS_PER_GROUP)
    a = -jnp.exp(a_log.astype(f32)).reshape(SSD_GROUPS, SSD_HEADS_PER_GROUP)
    y = ssd_chunked_scan(xs, dt, a, bm, cm)
    y = y + d_skip.astype(f32).reshape(SSD_GROUPS, SSD_HEADS_PER_GROUP, 1) * xs.astype(f32)
    h = (y.reshape(bn, s, SSD_D_INNER) * jax.nn.silu(z.astype(f32))).reshape(bn, s, SSD_GROUPS, -1)
    h = h * lax.rsqrt(jnp.mean(jnp.square(h), axis=-1, keepdims=True) + RMS_EPS)
    h = h.reshape(bn, s, SSD_D_INNER) * norm_w.astype(f32)
    return h.astype(x.dtype) @ out_proj


def shortconv_mixer(x, in_proj, conv_w, out_proj):
    bch = x @ in_proj
    gate_b = bch[..., :D_MODEL]
    gate_c = bch[..., D_MODEL:2 * D_MODEL]
    h = bch[..., 2 * D_MODEL:]
    y = gate_b * causal_dwconv(gate_c * h, conv_w)
    return y @ out_proj


def peer_ffn(x, wq, subkeys, u, v):
    bn, s, d = x.shape
    t = bn * s
    xt = x.reshape(t, d)
    q = (xt @ wq).reshape(t, PEER_HEADS, 2, PEER_HALF_DIM).astype(jnp.float32)
    sc = jnp.einsum('thid,hikd->thik', q, subkeys.astype(jnp.float32))
    s1, i1 = lax.top_k(sc[:, :, 0], PEER_TOPK)
    s2, i2 = lax.top_k(sc[:, :, 1], PEER_TOPK)
    cand = (s1[..., :, None] + s2[..., None, :]).reshape(t, PEER_HEADS, PEER_TOPK * PEER_TOPK)
    cidx = (i1[..., :, None] * PEER_NKEYS + i2[..., None, :]).reshape(t, PEER_HEADS, PEER_TOPK * PEER_TOPK)
    top_s, pos = lax.top_k(cand, PEER_TOPK)
    eidx = jnp.take_along_axis(cidx, pos, axis=-1)
    gates = jax.nn.softmax(top_s, axis=-1).astype(x.dtype)

    nb = t // PEER_TOKEN_BLOCK

    def block(args):
        xb, eb, gb = args
        ub = jnp.take(u, eb, axis=0)
        act = jax.nn.gelu(jnp.einsum('td,thkd->thk', xb, ub), approximate=False) * gb
        vb = jnp.take(v, eb, axis=0)
        return jnp.einsum('thk,thkd->td', act, vb)

    out = lax.map(block, (xt.reshape(nb, PEER_TOKEN_BLOCK, d),
                          eidx.reshape(nb, PEER_TOKEN_BLOCK, PEER_HEADS, PEER_TOPK),
                          gates.reshape(nb, PEER_TOKEN_BLOCK, PEER_HEADS, PEER_TOPK)))
    return out.reshape(bn, s, d)


def setup_inputs(seed: int = 0) -> dict:
    key = jax.random.key(seed)
    ks = jax.random.split(key, 24)
    n_ssd = (DEPTH + 1) // 2
    n_sc = DEPTH // 2
    nrm = jax.random.normal
    f32 = jnp.float32
    x = nrm(ks[0], (BATCH, SEQ, D_MODEL), f32)
    ssd_in_proj = nrm(ks[1], (n_ssd, D_MODEL, SSD_PROJ), f32) * D_MODEL ** -0.5
    ssd_conv_w = nrm(ks[2], (n_ssd, SSD_CONV, SSD_CONV_DIM), f32) * SSD_CONV ** -0.5
    ssd_conv_b = nrm(ks[3], (n_ssd, SSD_CONV_DIM), f32) * 0.01
    dt0 = jnp.exp(jax.random.uniform(ks[4], (n_ssd, SSD_HEADS), f32)
                  * (math.log(0.1) - math.log(0.001)) + math.log(0.001))
    ssd_dt_bias = dt0 + jnp.log(-jnp.expm1(-dt0))
    ssd_A_log = jnp.log(jax.random.uniform(ks[5], (n_ssd, SSD_HEADS), f32, minval=1.0, maxval=16.0))
    ssd_D = 1.0 + 0.1 * nrm(ks[6], (n_ssd, SSD_HEADS), f32)
    ssd_norm_w = 1.0 + 0.1 * nrm(ks[7], (n_ssd, SSD_D_INNER), f32)
    ssd_out_proj = nrm(ks[8], (n_ssd, SSD_D_INNER, D_MODEL), f32) * (SSD_D_INNER ** -0.5 * DEEPNORM_BETA)
    sc_in_proj = nrm(ks[9], (n_sc, D_MODEL, 3 * D_MODEL), f32) * D_MODEL ** -0.5
    sc_conv_w = nrm(ks[10], (n_sc, SC_WIDTH, D_MODEL), f32) * SC_WIDTH ** -0.5
    sc_out_proj = nrm(ks[11], (n_sc, D_MODEL, D_MODEL), f32) * (D_MODEL ** -0.5 * DEEPNORM_BETA)
    peer_wq = nrm(ks[12], (DEPTH, D_MODEL, PEER_HEADS * PEER_QUERY_DIM), f32) * D_MODEL ** -0.5
    peer_subkeys = nrm(ks[13], (DEPTH, PEER_HEADS, 2, PEER_NKEYS, PEER_HALF_DIM), f32) * PEER_HALF_DIM ** -0.5
    peer_u = nrm(ks[14], (DEPTH, PEER_EXPERTS, D_MODEL), f32) * D_MODEL ** -0.5
    peer_v = nrm(ks[15], (DEPTH, PEER_EXPERTS, D_MODEL), f32) * (DEEPNORM_BETA * PEER_HEADS ** -0.5)
    ln1_g = 1.0 + 0.1 * nrm(ks[16], (DEPTH, D_MODEL), f32)
    ln1_b = 0.01 * nrm(ks[17], (DEPTH, D_MODEL), f32)
    ln2_g = 1.0 + 0.1 * nrm(ks[18], (DEPTH, D_MODEL), f32)
    ln2_b = 0.01 * nrm(ks[19], (DEPTH, D_MODEL), f32)
    return {'x': x, 'ssd_in_proj': ssd_in_proj, 'ssd_conv_w': ssd_conv_w, 'ssd_conv_b': ssd_conv_b,
            'ssd_dt_bias': ssd_dt_bias, 'ssd_A_log': ssd_A_log, 'ssd_D': ssd_D, 'ssd_norm_w': ssd_norm_w,
            'ssd_out_proj': ssd_out_proj, 'sc_in_proj': sc_in_proj, 'sc_conv_w': sc_conv_w,
            'sc_out_proj': sc_out_proj, 'peer_wq': peer_wq, 'peer_subkeys': peer_subkeys,
            'peer_u': peer_u, 'peer_v': peer_v, 'ln1_g': ln1_g, 'ln1_b': ln1_b,
            'ln2_g': ln2_g, 'ln2_b': ln2_b}


def reference(x, ssd_in_proj, ssd_conv_w, ssd_conv_b, ssd_dt_bias, ssd_A_log, ssd_D, ssd_norm_w,
              ssd_out_proj, sc_in_proj, sc_conv_w, sc_out_proj, peer_wq, peer_subkeys,
              peer_u, peer_v, ln1_g, ln1_b, ln2_g, ln2_b):
    for i in range(DEPTH):
        j = i // N_MIXERS
        if i % N_MIXERS == 0:
            mix = ssd_mixer(x, ssd_in_proj[j], ssd_conv_w[j], ssd_conv_b[j], ssd_dt_bias[j],
                            ssd_A_log[j], ssd_D[j], ssd_norm_w[j], ssd_out_proj[j])
        else:
            mix = shortconv_mixer(x, sc_in_proj[j], sc_conv_w[j], sc_out_proj[j])
        x = layer_norm(DEEPNORM_ALPHA * x + mix, ln1_g[i], ln1_b[i])
        ffn = peer_ffn(x, peer_wq[i], peer_subkeys[i], peer_u[i], peer_v[i])
        x = layer_norm(DEEPNORM_ALPHA * x + ffn, ln2_g[i], ln2_b[i])
    return x
```

```cpp
#include <hip/hip_runtime.h>
#include <cstdio>
#include <cstdint>

#ifndef MK_DBG
#define MK_DBG 0
#endif
#ifndef MK_MULTI
#define MK_MULTI 1
#endif

namespace pg8 {
#define PG8_LAS __attribute__((address_space(3)))
typedef unsigned short bf16_t;
typedef short bf16x8 __attribute__((ext_vector_type(8)));
typedef float f32x4 __attribute__((ext_vector_type(4)));
typedef unsigned u32x4 __attribute__((ext_vector_type(4)));
constexpr int BM = 256, BK = 64, HALF = 128, HTB = HALF * BK * 2, STAGE_BYTES = 8 * HTB, NXCD = 8, WGM = 8;

__host__ __device__ __forceinline__ int lds_byte(int r, int c) { const int st = (r >> 4) * 2 + (c >> 5), rr = r & 15, cc = c & 31, ob = rr * 64 + cc * 2; return st * 1024 + (ob ^ (((ob >> 9) & 1) << 5)); }
__host__ __device__ __forceinline__ void stage_rc(int b, int& R, int& C) { const int st = b / 1024, sb = b % 1024, swz = sb ^ (((sb >> 9) & 1) << 5); R = (st >> 1) * 16 + swz / 64; C = (st & 1) * 32 + (swz % 64) / 2; }
__host__ __device__ __forceinline__ int perm32(int rho) { const int n = rho >> 4, i = rho & 15; return 8 * (i >> 2) + 4 * n + (i & 3); }

struct Unit { int pm, pn; };
struct Gemm { const bf16_t* A; const bf16_t* Bt; int M, N, K; };

struct StaticOrder {
    int nM, nN, nwg, G, c;
    __host__ __device__ void init(int M, int N, int G_, int c_) { nM = M / BM; nN = N / BM; nwg = nM * nN; G = G_; c = c_; }
    __host__ __device__ bool next(int i, Unit& u) const {
        const long L = (long)i * G + c; if (L >= nwg) return false;
        int wgid = (int)L; { const int q = nwg / NXCD, r = nwg % NXCD, xcd = wgid % NXCD, off = wgid / NXCD; wgid = (xcd < r ? xcd * (q + 1) : r * (q + 1) + (xcd - r) * q) + off; }
        const int nig = WGM * nN, gid = wgid / nig, fm = gid * WGM, gsz = (nM - fm) < WGM ? (nM - fm) : WGM;
        u.pm = fm + ((wgid % nig) % gsz); u.pn = (wgid % nig) / gsz; return true;
    }
    __device__ __forceinline__ void a_ready(const Unit&) const {}
    __device__ __forceinline__ void done(const Unit&) const {}
};

__device__ __forceinline__ unsigned cvt_pk_bf16(float lo, float hi) { unsigned r; asm volatile("v_cvt_pk_bf16_f32 %0, %1, %2" : "=v"(r) : "v"(lo), "v"(hi)); return r; }

struct EpiBf16 {
    static constexpr bool PERM = true, AFTER_DRAIN = false;
    bf16_t* O; int ldc;
    __device__ __forceinline__ void operator()(const f32x4 (&acc)[2][2][4][2], const Unit& u, int wr, int wc, int fr, int fq) const {
        const int row0 = u.pm * BM + wr * 64 + fr; const int col0 = u.pn * BM + wc * 32 + 8 * fq;
#pragma unroll
        for (int ai = 0; ai < 2; ++ai)
#pragma unroll
            for (int m = 0; m < 4; ++m) { bf16_t* rowp = O + (size_t)(row0 + ai * HALF + m * 16) * ldc + col0;
#pragma unroll
                for (int bj = 0; bj < 2; ++bj) { const f32x4 v0 = acc[ai][bj][m][0], v1 = acc[ai][bj][m][1];
                    u32x4 w; w.x = cvt_pk_bf16(v0[0], v0[1]); w.y = cvt_pk_bf16(v0[2], v0[3]); w.z = cvt_pk_bf16(v1[0], v1[1]); w.w = cvt_pk_bf16(v1[2], v1[3]);
                    *(u32x4*)(rowp + bj * HALF) = w; } }
    }
};
struct EpiF32 {
    static constexpr bool PERM = false, AFTER_DRAIN = false;
    float* C; int ldc;
    __device__ __forceinline__ void operator()(const f32x4 (&acc)[2][2][4][2], const Unit& u, int wr, int wc, int fr, int fq) const {
        const int row0 = u.pm * BM + wr * 64 + fr, col0 = u.pn * BM + wc * 32 + 4 * fq;
#pragma unroll
        for (int ai = 0; ai < 2; ++ai)
#pragma unroll
            for (int m = 0; m < 4; ++m) { float* rowp = C + (size_t)(row0 + ai * HALF + m * 16) * ldc + col0;
#pragma unroll
                for (int bj = 0; bj < 2; ++bj)
#pragma unroll
                    for (int n = 0; n < 2; ++n) *(f32x4*)(rowp + bj * HALF + n * 16) = acc[ai][bj][m][n]; }
    }
};
struct EpiRes {
    static constexpr bool PERM = false, AFTER_DRAIN = false;
    const float* res; float* out; int ldc; float alpha;
    __device__ __forceinline__ void operator()(const f32x4 (&acc)[2][2][4][2], const Unit& u, int wr, int wc, int fr, int fq) const {
        const int row0 = u.pm * BM + wr * 64 + fr, col0 = u.pn * BM + wc * 32 + 4 * fq;
#pragma unroll
        for (int ai = 0; ai < 2; ++ai)
#pragma unroll
            for (int m = 0; m < 4; ++m) { const size_t off = (size_t)(row0 + ai * HALF + m * 16) * ldc + col0;
#pragma unroll
                for (int bj = 0; bj < 2; ++bj)
#pragma unroll
                    for (int n = 0; n < 2; ++n) { const f32x4 r = *(const f32x4*)(res + off + bj * HALF + n * 16); *(f32x4*)(out + off + bj * HALF + n * 16) = r * alpha + acc[ai][bj][m][n]; }
                asm volatile("" ::: "memory"); }
    }
};

template <class Epi, class Sched, bool ALIGN_EPI = false, bool SP2 = false>
__device__ __forceinline__ void gemm_phase(PG8_LAS unsigned char* lds, const Gemm g, const Sched& S, const Epi& E) {
    int tid_ = threadIdx.x; asm volatile("" : "+v"(tid_));
    const int tid = tid_, wid = __builtin_amdgcn_readfirstlane(tid >> 6), lane = tid & 63, wr = wid >> 2, wc = wid & 3, fr = lane & 15, fq = lane >> 4;
    const int K = g.K, nt = K / BK;
    unsigned voffA[2], voffB[2];
#pragma unroll
    for (int i = 0; i < 2; ++i) { int R, C; stage_rc(tid * 16 + i * 8192, R, C); const int Rb = Epi::PERM ? ((R & ~31) + perm32(R & 31)) : R;
        voffA[i] = (unsigned)(R * K + C) * 2u; voffB[i] = (unsigned)(Rb * K + C) * 2u; }
    const size_t kstep = (size_t)(BK * 2);
    const size_t hstep = (size_t)HALF * K * 2;
    const size_t tstep = 2 * hstep;
    const unsigned ldsw = (unsigned)wid * 1024u;
    const int aoff = lds_byte(wr * 64 + fr, fq * 8), boff = lds_byte(wc * 32 + fr, fq * 8);
#define PG8_SA(b, h) (((b) * 2 + (h)) * HTB)
#define PG8_SB(b, h) ((4 + (b) * 2 + (h)) * HTB)
#define PG8_STAGE(bufoff, gbase, voff) do { _Pragma("unroll") for (int _i = 0; _i < 2; ++_i) \
        __builtin_amdgcn_global_load_lds((const unsigned*)((const char*)(gbase) + (voff)[_i]), (PG8_LAS unsigned*)(lds + (bufoff) + ldsw + _i * 8192), 16, 0, 0); } while (0)
#define PG8_LDA(dst, b, h) do { _Pragma("unroll") for (int m = 0; m < 4; ++m) _Pragma("unroll") for (int k = 0; k < 2; ++k) dst[m][k] = *(const PG8_LAS bf16x8*)(lds + PG8_SA(b, h) + aoff + m * 2048 + k * 1024); } while (0)
#define PG8_LDB(dst, b, h) do { _Pragma("unroll") for (int n = 0; n < 2; ++n) _Pragma("unroll") for (int k = 0; k < 2; ++k) dst[n][k] = *(const PG8_LAS bf16x8*)(lds + PG8_SB(b, h) + boff + n * 2048 + k * 1024); } while (0)
#define PG8_MMA(ai, bj, At, Bt) do { __builtin_amdgcn_s_setprio(1); _Pragma("unroll") for (int m = 0; m < 4; ++m) _Pragma("unroll") for (int n = 0; n < 2; ++n) _Pragma("unroll") for (int k = 0; k < 2; ++k) \
        acc[ai][bj][m][n] = __builtin_amdgcn_mfma_f32_16x16x32_bf16(Bt[n][k], At[m][k], acc[ai][bj][m][n], 0, 0, 0); __builtin_amdgcn_s_setprio(0); } while (0)
#define PG8_WAIT_V(n) asm volatile("s_waitcnt vmcnt(" #n ")" ::: "memory")
#define PG8_WAIT_L(n) asm volatile("s_waitcnt lgkmcnt(" #n ")" ::: "memory")
#define PG8_BAR __builtin_amdgcn_s_barrier()
#define PG8_SCHED __builtin_amdgcn_sched_barrier(0)
    Unit cur, nxt; int ui = 0;
    if (!S.next(0, cur)) return;
    f32x4 acc[2][2][4][2];
#pragma unroll
    for (int a = 0; a < 2; ++a)
#pragma unroll
        for (int b = 0; b < 2; ++b)
#pragma unroll
            for (int m = 0; m < 4; ++m)
#pragma unroll
                for (int n = 0; n < 2; ++n) acc[a][b][m][n] = (f32x4){0.f, 0.f, 0.f, 0.f};
    bf16x8 At[4][2], B0[2][2], B1[2][2];
    const char* cA = (const char*)g.A + (size_t)cur.pm * tstep; const char* cB = (const char*)g.Bt + (size_t)cur.pn * tstep;
    S.a_ready(cur);
    if constexpr (SP2) {
        PG8_STAGE(PG8_SB(0, 0), cB, voffB); PG8_STAGE(PG8_SB(0, 1), cB + hstep, voffB); PG8_STAGE(PG8_SA(0, 0), cA, voffA); PG8_STAGE(PG8_SA(0, 1), cA + hstep, voffA);
        if (wr == 1) PG8_BAR;
        PG8_WAIT_V(2); PG8_BAR;
        PG8_STAGE(PG8_SB(1, 0), cB + kstep, voffB); PG8_STAGE(PG8_SA(1, 0), cA + kstep, voffA); PG8_STAGE(PG8_SB(1, 1), cB + hstep + kstep, voffB);
        PG8_WAIT_V(6); PG8_BAR;
    } else {
        PG8_STAGE(PG8_SB(0, 0), cB, voffB); PG8_STAGE(PG8_SA(0, 0), cA, voffA); PG8_STAGE(PG8_SB(0, 1), cB + hstep, voffB); PG8_STAGE(PG8_SA(0, 1), cA + hstep, voffA);
        if (wr == 1) PG8_BAR;
        PG8_WAIT_V(4); PG8_BAR;
        PG8_STAGE(PG8_SB(1, 0), cB + kstep, voffB); PG8_STAGE(PG8_SA(1, 0), cA + kstep, voffA); PG8_STAGE(PG8_SB(1, 1), cB + hstep + kstep, voffB);
        PG8_WAIT_V(6); PG8_BAR;
    }
    for (;;) {
        const bool has_next = S.next(ui + 1, nxt);
        const char* nA = has_next ? (const char*)g.A + (size_t)nxt.pm * tstep : cA; const char* nB = has_next ? (const char*)g.Bt + (size_t)nxt.pn * tstep : cB;
        for (int t = 0; t < nt; t += 2) {
            const bool last = (t == nt - 2);
            const char* a1 = cA + (size_t)(t + 1) * kstep;
            const char* a2 = last ? nA : cA + (size_t)(t + 2) * kstep; const char* b2 = last ? nB : cB + (size_t)(t + 2) * kstep;
            const char* a3 = a2 + kstep; const char* b3 = b2 + kstep;
            if (last && has_next) S.a_ready(nxt);
            if constexpr (SP2) {
            PG8_LDB(B0, 0, 0); PG8_LDB(B1, 0, 1); PG8_SCHED; PG8_LDA(At, 0, 0); PG8_STAGE(PG8_SA(1, 1), a1 + hstep, voffA);
            PG8_WAIT_V(8); PG8_WAIT_L(0); PG8_BAR; PG8_MMA(0, 0, At, B0); PG8_MMA(0, 1, At, B1); PG8_BAR; PG8_SCHED;
            PG8_LDA(At, 0, 1); PG8_STAGE(PG8_SB(0, 0), b2, voffB); PG8_STAGE(PG8_SB(0, 1), b2 + hstep, voffB); PG8_STAGE(PG8_SA(0, 0), a2, voffA);
            PG8_WAIT_V(8); PG8_WAIT_L(0); PG8_BAR; PG8_MMA(1, 0, At, B0); PG8_MMA(1, 1, At, B1); PG8_BAR; PG8_SCHED;
            PG8_LDB(B0, 1, 0); PG8_LDB(B1, 1, 1); PG8_SCHED; PG8_LDA(At, 1, 0); PG8_STAGE(PG8_SA(0, 1), a2 + hstep, voffA);
            PG8_WAIT_V(8); PG8_WAIT_L(0); PG8_BAR; PG8_MMA(0, 0, At, B0); PG8_MMA(0, 1, At, B1); PG8_BAR; PG8_SCHED;
            PG8_LDA(At, 1, 1); PG8_STAGE(PG8_SB(1, 0), b3, voffB); PG8_STAGE(PG8_SB(1, 1), b3 + hstep, voffB); PG8_STAGE(PG8_SA(1, 0), a3, voffA);
            PG8_WAIT_V(8); PG8_WAIT_L(0); PG8_BAR; PG8_MMA(1, 0, At, B0); PG8_MMA(1, 1, At, B1); PG8_BAR; PG8_SCHED;
            } else {
            PG8_LDB(B0, 0, 0); PG8_SCHED; PG8_LDA(At, 0, 0); PG8_STAGE(PG8_SA(1, 1), a1 + hstep, voffA);
            PG8_WAIT_L(8); PG8_BAR; PG8_WAIT_L(0); PG8_MMA(0, 0, At, B0); PG8_BAR; PG8_SCHED;
            PG8_LDB(B1, 0, 1); PG8_STAGE(PG8_SB(0, 0), b2, voffB);
            PG8_BAR; PG8_WAIT_L(0); PG8_MMA(0, 1, At, B1); PG8_BAR;
            PG8_LDA(At, 0, 1); PG8_STAGE(PG8_SA(0, 0), a2, voffA);
            PG8_BAR; PG8_WAIT_L(0); PG8_MMA(1, 0, At, B0); PG8_BAR; PG8_SCHED;
            PG8_STAGE(PG8_SB(0, 1), b2 + hstep, voffB);
            PG8_WAIT_V(6); PG8_BAR; PG8_MMA(1, 1, At, B1); PG8_BAR;
            PG8_LDB(B0, 1, 0); PG8_SCHED; PG8_LDA(At, 1, 0); PG8_STAGE(PG8_SA(0, 1), a2 + hstep, voffA);
            PG8_WAIT_L(8); PG8_BAR; PG8_WAIT_L(0); PG8_MMA(0, 0, At, B0); PG8_BAR; PG8_SCHED;
            PG8_LDB(B1, 1, 1); PG8_STAGE(PG8_SB(1, 0), b3, voffB);
            PG8_BAR; PG8_WAIT_L(0); PG8_MMA(0, 1, At, B1); PG8_BAR;
            PG8_LDA(At, 1, 1); PG8_STAGE(PG8_SA(1, 0), a3, voffA);
            PG8_BAR; PG8_WAIT_L(0); PG8_MMA(1, 0, At, B0); PG8_BAR; PG8_SCHED;
            PG8_STAGE(PG8_SB(1, 1), b3 + hstep, voffB);
            PG8_WAIT_V(6); PG8_BAR; PG8_MMA(1, 1, At, B1); PG8_BAR;
            }
        }
        if constexpr (ALIGN_EPI) { if (wr == 0) PG8_BAR; }
        if constexpr (!Epi::AFTER_DRAIN) { E(acc, cur, wr, wc, fr, fq); S.done(cur); }
        if (!has_next) break;
#pragma unroll
        for (int a = 0; a < 2; ++a)
#pragma unroll
            for (int b = 0; b < 2; ++b)
#pragma unroll
                for (int m = 0; m < 4; ++m)
#pragma unroll
                    for (int n = 0; n < 2; ++n) acc[a][b][m][n] = (f32x4){0.f, 0.f, 0.f, 0.f};
        cur = nxt; cA = nA; cB = nB; ++ui;
        if constexpr (ALIGN_EPI) { if (wr == 1) PG8_BAR; }
    }
    PG8_WAIT_V(0);
    if constexpr (!ALIGN_EPI) { if (wr == 0) PG8_BAR; }
    PG8_BAR;
#undef PG8_SA
#undef PG8_SB
#undef PG8_STAGE
#undef PG8_LDA
#undef PG8_LDB
#undef PG8_MMA
#undef PG8_WAIT_V
#undef PG8_WAIT_L
#undef PG8_BAR
#undef PG8_SCHED
}
}

constexpr int NWAVES = 8, NTHREADS = 512;
constexpr int D = 4096, BATCH = 4, SEQ = 4096, T = BATCH * SEQ, DEPTH = 4;
constexpr int DI = 8192, HD = 64, NH = 128, NG = 8, NST = 128, CONVD = DI + 2 * NG * NST  , PROJ = DI + CONVD + NH  , PROJP = 18688  ;
constexpr int PH = 8, NK = 128, PK = 16, HALFD = 128, QD = PH * 2 * HALFD  , NEXP = NK * NK;
constexpr float LN_EPS = 1e-5f, RMS_EPS = 1e-5f;
constexpr float ALPHA = 1.681792830507429f;

constexpr size_t MiB = 1u << 20;
constexpr size_t WS_CTL = 0, CTL_ZERO_BYTES = 1 * MiB;
constexpr size_t SZ_W_SSD_IN = (size_t)PROJP * D * 2, SZ_W_SSD_OUT = (size_t)D * DI * 2, SZ_W_SC_IN = (size_t)3 * D * D * 2, SZ_W_SC_OUT = (size_t)D * D * 2, SZ_W_WQ = (size_t)QD * D * 2, SZ_W_UV = (size_t)NEXP * D * 2;
constexpr size_t WS_W_SSD_IN = 1 * MiB;
constexpr size_t WS_W_SSD_OUT = WS_W_SSD_IN + 2 * SZ_W_SSD_IN;
constexpr size_t WS_W_SC_IN = WS_W_SSD_OUT + 2 * SZ_W_SSD_OUT;
constexpr size_t WS_W_SC_OUT = WS_W_SC_IN + 2 * SZ_W_SC_IN;
constexpr size_t WS_W_WQ = WS_W_SC_OUT + 2 * SZ_W_SC_OUT;
constexpr size_t WS_W_U = WS_W_WQ + 4 * SZ_W_WQ;
constexpr size_t WS_W_V = WS_W_U + 4 * SZ_W_UV;
constexpr size_t WS_X32 = WS_W_V + 4 * SZ_W_UV;
constexpr size_t WS_XB = WS_X32 + (size_t)T * D * 4;
constexpr size_t WS_ZX = WS_XB + (size_t)T * D * 2;
constexpr size_t WS_XBC = WS_ZX + (size_t)T * PROJP * 2;
constexpr size_t WS_YB = WS_XBC + (size_t)T * CONVD * 2;
constexpr size_t WS_Q32 = WS_YB + (size_t)T * DI * 2;
constexpr size_t WS_DT = WS_Q32 + (size_t)T * QD * 4;
constexpr size_t WS_DA = WS_DT + (size_t)T * NH * 4;
constexpr size_t WS_EIDX = WS_DA + (size_t)T * NH * 4;
constexpr size_t WS_GATES = WS_EIDX + (size_t)T * 128 * 4;
constexpr size_t WS_HDBG = WS_GATES + (size_t)T * 128 * 4;
constexpr size_t WS_END = WS_HDBG + (size_t)T * 128 * 4;
static_assert(WS_END <= (size_t)4096 * MiB, "workspace map exceeds 4 GiB");
constexpr int CW_BAR = 4096;

constexpr int RING_BYTES = 131072;
constexpr int LDSCTL_OFF = RING_BYTES, MISC_OFF = LDSCTL_OFF + 320;
constexpr int LDS_BYTES = 147456;

#define GAS __attribute__((address_space(1)))
#define LAS __attribute__((address_space(3)))
typedef unsigned short bf16;
typedef unsigned v4u __attribute__((ext_vector_type(4)));
typedef float f32x4 __attribute__((ext_vector_type(4)));
typedef float f32x2 __attribute__((ext_vector_type(2)));
typedef __bf16 bf16x2_t __attribute__((ext_vector_type(2)));

__device__ __forceinline__ float bf_lo(unsigned w) { return __uint_as_float(w << 16); }
__device__ __forceinline__ float bf_hi(unsigned w) { return __uint_as_float(w & 0xffff0000u); }
__device__ __forceinline__ unsigned pk2(float lo, float hi) { return pg8::cvt_pk_bf16(lo, hi); }
__device__ __forceinline__ float wave_sum(float v) {
#pragma unroll
    for (int o = 1; o < 64; o <<= 1) v += __shfl_xor(v, o);
    return v;
}
__device__ __forceinline__ float wave_max(float v) {
#pragma unroll
    for (int o = 1; o < 64; o <<= 1) v = fmaxf(v, __shfl_xor(v, o));
    return v;
}
__device__ __forceinline__ float dot2bf(unsigned a, unsigned b, float acc) { return __builtin_amdgcn_fdot2_f32_bf16(__builtin_bit_cast(bf16x2_t, a), __builtin_bit_cast(bf16x2_t, b), acc, false); }
__device__ __forceinline__ float dot8(const v4u a, const v4u b, float s) { s = dot2bf(a.x, b.x, s); s = dot2bf(a.y, b.y, s); s = dot2bf(a.z, b.z, s); s = dot2bf(a.w, b.w, s); return s; }
__device__ __forceinline__ float silu_f(float x) { return x / (1.f + __expf(-x)); }

#define XB_TMO      128
#define XB_XCNT(j)  (256  + 64 * (j))
#define XB_XSUB(j)  (1280 + 64 * (j))
#define XB_XGEN(j)  (2304 + 64 * (j))
#define XB_TOP      3328
#define XB_TOPGEN   3392
#define XCD_BAR_WORDS 3456
#define XB_SPIN_CAP (1u << 18)
__device__ __forceinline__ unsigned xb_ld(unsigned* p)              { return __hip_atomic_load(p, __ATOMIC_RELAXED, __HIP_MEMORY_SCOPE_AGENT); }
__device__ __forceinline__ unsigned xb_add(unsigned* p, unsigned v) { return __hip_atomic_fetch_add(p, v, __ATOMIC_RELAXED, __HIP_MEMORY_SCOPE_AGENT); }
__device__ __forceinline__ unsigned xb_xcc_id() { return (unsigned)__builtin_amdgcn_s_getreg((3 << 11) | 20) & 0xFu; }
#define XB_SPIN(cond, bar) do { unsigned _sp = 0; while (cond) { __builtin_amdgcn_s_sleep(1); \
    if ((++_sp & 255u) == 0u) { if (xb_ld(&(bar)[XB_TMO])) break; if (_sp > XB_SPIN_CAP) { atomicAdd(&(bar)[XB_TMO], 1u); break; } } } } while (0)
struct XcdBarrier { unsigned* bar; unsigned x; volatile LAS unsigned* st; };
__device__ __forceinline__ XcdBarrier xcd_barrier_post(unsigned* bar, volatile LAS unsigned* st) {
    XcdBarrier b; b.bar = bar; b.x = xb_xcc_id(); b.st = st;
    if (threadIdx.x == 0) (void)xb_add(&bar[XB_XCNT(b.x)], 1u);
    return b;
}
__device__ __forceinline__ void xcd_barrier_complete(unsigned* bar, unsigned x, unsigned& nloc, unsigned& nx) {
    const unsigned G = gridDim.x * gridDim.y * gridDim.z;
    unsigned sum, cnt, mine, sp = 0u;
    for (;;) {
        sum = 0u; cnt = 0u; mine = 0u;
#pragma unroll
        for (unsigned j = 0; j < 16; ++j) { const unsigned c = xb_ld(&bar[XB_XCNT(j)]); sum += c; cnt += (c > 0u) ? 1u : 0u; mine = (j == x) ? c : mine; }
        if (sum == G) break;
        __builtin_amdgcn_s_sleep(1);
        if ((++sp & 255u) == 0u) { if (xb_ld(&bar[XB_TMO])) break; if (sp > XB_SPIN_CAP) { atomicAdd(&bar[XB_TMO], 1u); break; } }
    }
    nloc = mine > 0u ? mine : 1u; nx = cnt > 0u ? cnt : 1u;
}
__device__ __forceinline__ void xcd_barrier(const XcdBarrier& b) {
    asm volatile("s_waitcnt vmcnt(0)" ::: "memory");
    __syncthreads();
    if (threadIdx.x == 0) {
        unsigned* bar = b.bar;
        __builtin_amdgcn_s_waitcnt(0);
        unsigned nloc = b.st[0], nx = b.st[1];
        if (nloc == 0u) { xcd_barrier_complete(bar, b.x, nloc, nx); b.st[0] = nloc; b.st[1] = nx; }
        const unsigned old = xb_add(&bar[XB_XSUB(b.x)], 1u);
        const unsigned gen = old / nloc;
        if (old + 1u == (gen + 1u) * nloc) {
            __builtin_amdgcn_fence(__ATOMIC_RELEASE, "agent");
            asm volatile("s_waitcnt vmcnt(0)" ::: "memory");
            const unsigned og = xb_add(&bar[XB_TOP], 1u);
            const unsigned tg = og / nx;
            if (og + 1u == (tg + 1u) * nx) xb_add(&bar[XB_TOPGEN], 1u);
            else XB_SPIN(xb_ld(&bar[XB_TOPGEN]) == tg, bar);
            __builtin_amdgcn_fence(__ATOMIC_ACQUIRE, "agent");
            xb_add(&bar[XB_XGEN(b.x)], 1u);
            asm volatile("s_waitcnt vmcnt(0)" ::: "memory");
        } else {
            XB_SPIN(xb_ld(&bar[XB_XGEN(b.x)]) == gen, bar);
            __builtin_amdgcn_fence(__ATOMIC_ACQUIRE, "agent");
            asm volatile("s_waitcnt vmcnt(0)" ::: "memory");
        }
    }
    __syncthreads();
}

struct Args {
    const float* in[20]; float* out; unsigned char* ws; int ph_lo, ph_hi, use_bar, pad;
};
typedef const __attribute__((address_space(4))) Args* KArgs;
#define KA() ({ KArgs p_ = (KArgs)__builtin_amdgcn_kernarg_segment_ptr(); asm volatile("" : "+s"(p_)); p_; })
struct Frame {
    LAS unsigned char* lds;
    int tid, lane, wave, G, gw, NGW;
};

__device__ __forceinline__ void p0_transpose_item(const float* __restrict__ W, int K, int N, bf16* WT, LAS float* scr, int item, int lane) {
    const int nblk = N / 32, kb = item / nblk, nb = item % nblk, k0 = 64 * kb, n0 = 32 * nb;
#pragma unroll 8
    for (int i = 0; i < 32; ++i) { const int kk = 2 * i + (lane >> 5); scr[kk * 33 + (lane & 31)] = W[(size_t)(k0 + kk) * N + n0 + (lane & 31)]; }
    asm volatile("s_waitcnt lgkmcnt(0)" ::: "memory");
    const int c = lane & 7;
#pragma unroll
    for (int j = 0; j < 4; ++j) { const int n = (lane >> 3) + 8 * j; const LAS float* s = scr + (8 * c) * 33 + n;
        v4u o; o.x = pk2(s[0 * 33], s[1 * 33]); o.y = pk2(s[2 * 33], s[3 * 33]); o.z = pk2(s[4 * 33], s[5 * 33]); o.w = pk2(s[6 * 33], s[7 * 33]);
        *(v4u*)(WT + (size_t)(n0 + n) * K + k0 + 8 * c) = o; }
    asm volatile("s_waitcnt lgkmcnt(0)" ::: "memory");
}
__device__ __forceinline__ void cvt_rows(const float* __restrict__ src, bf16* dst, size_t n8, size_t gtid, size_t nthr) {
    for (size_t i = gtid; i < n8; i += nthr) { const f32x4 a = ((const f32x4*)src)[2 * i], b = ((const f32x4*)src)[2 * i + 1];
        v4u o; o.x = pk2(a[0], a[1]); o.y = pk2(a[2], a[3]); o.z = pk2(b[0], b[1]); o.w = pk2(b[2], b[3]); ((v4u*)dst)[i] = o; }
}
__device__ __forceinline__ void p0_prologue(const Frame& F, KArgs a) {
    unsigned char* ws = a->ws;
    LAS float* scr = (LAS float*)(F.lds + F.wave * 16384);
    constexpr int I_SSD_IN = (D / 64) * (PROJ / 32), I_SSD_OUT = (DI / 64) * (D / 32), I_SC_IN = (D / 64) * (3 * D / 32), I_SC_OUT = (D / 64) * (D / 32), I_WQ = (D / 64) * (QD / 32);
    constexpr int NITEMS = 2 * (I_SSD_IN + I_SSD_OUT + I_SC_IN + I_SC_OUT) + 4 * I_WQ;
    for (int it = F.gw; it < NITEMS; it += F.NGW) {
        int r = it;
        if (r < 2 * I_SSD_IN) { const int j = r / I_SSD_IN; r -= j * I_SSD_IN; p0_transpose_item(a->in[1] + (size_t)j * D * PROJ, D, PROJ, (bf16*)(ws + WS_W_SSD_IN + j * SZ_W_SSD_IN), scr, r, F.lane); continue; } r -= 2 * I_SSD_IN;
        if (r < 2 * I_SSD_OUT) { const int j = r / I_SSD_OUT; r -= j * I_SSD_OUT; p0_transpose_item(a->in[8] + (size_t)j * DI * D, DI, D, (bf16*)(ws + WS_W_SSD_OUT + j * SZ_W_SSD_OUT), scr, r, F.lane); continue; } r -= 2 * I_SSD_OUT;
        if (r < 2 * I_SC_IN) { const int j = r / I_SC_IN; r -= j * I_SC_IN; p0_transpose_item(a->in[9] + (size_t)j * D * 3 * D, D, 3 * D, (bf16*)(ws + WS_W_SC_IN + j * SZ_W_SC_IN), scr, r, F.lane); continue; } r -= 2 * I_SC_IN;
        if (r < 2 * I_SC_OUT) { const int j = r / I_SC_OUT; r -= j * I_SC_OUT; p0_transpose_item(a->in[11] + (size_t)j * D * D, D, D, (bf16*)(ws + WS_W_SC_OUT + j * SZ_W_SC_OUT), scr, r, F.lane); continue; } r -= 2 * I_SC_OUT;
        { const int j = r / I_WQ; r -= j * I_WQ; p0_transpose_item(a->in[12] + (size_t)j * D * QD, D, QD, (bf16*)(ws + WS_W_WQ + j * SZ_W_WQ), scr, r, F.lane); }
    }
    const size_t gtid = (size_t)blockIdx.x * NTHREADS + F.tid, nthr = (size_t)F.G * NTHREADS;
    for (int j = 0; j < 2; ++j) { v4u* p = (v4u*)(ws + WS_W_SSD_IN + j * SZ_W_SSD_IN + (size_t)PROJ * D * 2); const size_t n16 = (size_t)(PROJP - PROJ) * D * 2 / 16;
        for (size_t i = gtid; i < n16; i += nthr) p[i] = (v4u){0u, 0u, 0u, 0u}; }
    cvt_rows(a->in[14], (bf16*)(ws + WS_W_U), (size_t)4 * NEXP * D / 8, gtid, nthr);
    cvt_rows(a->in[15], (bf16*)(ws + WS_W_V), (size_t)4 * NEXP * D / 8, gtid, nthr);
    cvt_rows(a->in[0], (bf16*)(ws + WS_XB), (size_t)T * D / 8, gtid, nthr);
}

__device__ __forceinline__ void ssd_conv_phase(const Frame& F, KArgs a, int j) {
    const bf16* ZX = (const bf16*)(a->ws + WS_ZX); bf16* XBC = (bf16*)(a->ws + WS_XBC);
    const float* cw = a->in[2] + (size_t)j * 4 * CONVD; const float* cb = a->in[3] + (size_t)j * CONVD;
    constexpr int NCB = CONVD / 512, NITEMS = (T / 32) * NCB;
    for (int it = F.gw; it < NITEMS; it += F.NGW) {
        const int tb = it / NCB, cbk = it % NCB, c0 = cbk * 512 + F.lane * 8, t0 = tb * 32;
        float w[4][8], bias[8];
#pragma unroll
        for (int k = 0; k < 4; ++k) { const f32x4 u0 = *(const f32x4*)(cw + (size_t)k * CONVD + c0), u1 = *(const f32x4*)(cw + (size_t)k * CONVD + c0 + 4);
#pragma unroll
            for (int e = 0; e < 4; ++e) { w[k][e] = u0[e]; w[k][4 + e] = u1[e]; } }
        { const f32x4 u0 = *(const f32x4*)(cb + c0), u1 = *(const f32x4*)(cb + c0 + 4);
#pragma unroll
          for (int e = 0; e < 4; ++e) { bias[e] = u0[e]; bias[4 + e] = u1[e]; } }
        float r0[8], r1[8], r2[8];
        const bool head = (t0 % SEQ) == 0;
#pragma unroll
        for (int h = 0; h < 3; ++h) {
            v4u v = (v4u){0u, 0u, 0u, 0u};
            if (!head) v = *(const v4u*)(ZX + (size_t)(t0 - 3 + h) * PROJP + DI + c0);
            float* dst = h == 0 ? r0 : (h == 1 ? r1 : r2);
#pragma unroll
            for (int e = 0; e < 4; ++e) { dst[2 * e] = bf_lo(v[e]); dst[2 * e + 1] = bf_hi(v[e]); }
        }
        for (int tt = 0; tt < 32; ++tt) {
            const v4u v = *(const v4u*)(ZX + (size_t)(t0 + tt) * PROJP + DI + c0);
            float cur[8], o[8];
#pragma unroll
            for (int e = 0; e < 4; ++e) { cur[2 * e] = bf_lo(v[e]); cur[2 * e + 1] = bf_hi(v[e]); }
#pragma unroll
            for (int e = 0; e < 8; ++e) { const float s = bias[e] + w[0][e] * r0[e] + w[1][e] * r1[e] + w[2][e] * r2[e] + w[3][e] * cur[e]; o[e] = silu_f(s); r0[e] = r1[e]; r1[e] = r2[e]; r2[e] = cur[e]; }
            v4u ov; ov.x = pk2(o[0], o[1]); ov.y = pk2(o[2], o[3]); ov.z = pk2(o[4], o[5]); ov.w = pk2(o[6], o[7]);
            *(v4u*)(XBC + (size_t)(t0 + tt) * CONVD + c0) = ov;
        }
    }
    float* DT = (float*)(a->ws + WS_DT); float* DA = (float*)(a->ws + WS_DA);
    const float* dtb = a->in[4] + j * NH; const float* alog = a->in[5] + j * NH;
    const size_t gtid = (size_t)blockIdx.x * NTHREADS + F.tid, nthr = (size_t)F.G * NTHREADS;
    for (size_t i = gtid; i < (size_t)T * NH; i += nthr) {
        const int h = (int)(i % NH); const size_t t = i / NH;
        const float raw = __uint_as_float((unsigned)ZX[t * PROJP + DI + CONVD + h] << 16) + dtb[h];
        const float dt = raw > 20.f ? raw : log1pf(expf(raw));
        const float av = -expf(alog[h]);
        DT[i] = dt; DA[i] = expf(dt * av);
    }
}

__device__ __forceinline__ void ssd_scan_phase(const Frame& F, KArgs a, int j) {
    const bf16* XBC = (const bf16*)(a->ws + WS_XBC); bf16* YB = (bf16*)(a->ws + WS_YB);
    const float* DT = (const float*)(a->ws + WS_DT); const float* DA = (const float*)(a->ws + WS_DA);
    const float* Dsk = a->in[6] + j * NH;
    LAS float* Bs = (LAS float*)(F.lds);
    LAS float* Cs = (LAS float*)(F.lds + 16384);
    LAS float* Xs = (LAS float*)(F.lds + 32768);
    LAS float* DTs = (LAS float*)(F.lds + 49152);
    LAS float* DAs = (LAS float*)(F.lds + 49152 + 256);
    LAS float* YP = (LAS float*)(F.lds + 65536);
    const int hl = F.wave >> 2, nq = F.wave & 3;
    for (int unit = blockIdx.x; unit < BATCH * (NH / 2); unit += F.G) {
        const int b = unit / (NH / 2), hp = unit % (NH / 2), g = hp >> 3, hg0 = 2 * hp;
        float hst[32];
#pragma unroll
        for (int n = 0; n < 32; ++n) hst[n] = 0.f;
        for (int blk = 0; blk < SEQ / 32; ++blk) {
            const size_t tg0 = (size_t)b * SEQ + (size_t)blk * 32;
            {
                const int tt = F.tid >> 4, col = (F.tid & 15) * 8; const bf16* rowp = XBC + (tg0 + tt) * CONVD;
                const v4u vb = *(const v4u*)(rowp + DI + g * NST + col), vc = *(const v4u*)(rowp + DI + NG * NST + g * NST + col), vx = *(const v4u*)(rowp + hg0 * HD + col);
#pragma unroll
                for (int e = 0; e < 4; ++e) { Bs[tt * 128 + col + 2 * e] = bf_lo(vb[e]); Bs[tt * 128 + col + 2 * e + 1] = bf_hi(vb[e]);
                    Cs[tt * 128 + col + 2 * e] = bf_lo(vc[e]); Cs[tt * 128 + col + 2 * e + 1] = bf_hi(vc[e]);
                    Xs[tt * 128 + col + 2 * e] = bf_lo(vx[e]); Xs[tt * 128 + col + 2 * e + 1] = bf_hi(vx[e]); }
                if (F.tid < 64) { const int t2 = F.tid >> 1, hh = F.tid & 1; DTs[t2 * 2 + hh] = DT[(tg0 + t2) * NH + hg0 + hh]; DAs[t2 * 2 + hh] = DA[(tg0 + t2) * NH + hg0 + hh]; }
            }
            __syncthreads();
            for (int tt = 0; tt < 32; ++tt) {
                const float dtv = DTs[tt * 2 + hl], dav = DAs[tt * 2 + hl], xv = Xs[tt * 128 + hl * 64 + F.lane];
                const float dx = dtv * xv; float y = 0.f;
#pragma unroll
                for (int n4 = 0; n4 < 8; ++n4) {
                    const f32x4 bv = *(const LAS f32x4*)(Bs + tt * 128 + nq * 32 + n4 * 4), cv = *(const LAS f32x4*)(Cs + tt * 128 + nq * 32 + n4 * 4);
#pragma unroll
                    for (int e = 0; e < 4; ++e) { hst[n4 * 4 + e] = dav * hst[n4 * 4 + e] + dx * bv[e]; y += cv[e] * hst[n4 * 4 + e]; }
                }
                YP[(tt * 8 + F.wave) * 64 + F.lane] = y;
            }
            __syncthreads();
#pragma unroll
            for (int k = 0; k < 8; ++k) {
                const int idx = F.tid + 512 * k, tt = idx >> 7, ch = idx & 127, h2 = ch >> 6, p = ch & 63;
                float y = Dsk[hg0 + h2] * Xs[tt * 128 + ch];
#pragma unroll
                for (int q = 0; q < 4; ++q) y += YP[(tt * 8 + h2 * 4 + q) * 64 + p];
                YB[(tg0 + tt) * DI + hg0 * HD + ch] = (bf16)(pk2(y, 0.f) & 0xffffu);
            }
            __syncthreads();
        }
    }
}

__device__ __forceinline__ void ssd_gate_phase(const Frame& F, KArgs a, int j) {
    const bf16* ZX = (const bf16*)(a->ws + WS_ZX); const bf16* YB = (const bf16*)(a->ws + WS_YB); bf16* HB = (bf16*)(a->ws + WS_XBC);
    const float* nw = a->in[7] + (size_t)j * DI;
    for (int it = F.gw; it < T * NG; it += F.NGW) {
        const int t = it >> 3, g = it & 7, c = g * 1024 + F.lane * 16;
        float h[16]; float ss = 0.f;
#pragma unroll
        for (int q = 0; q < 2; ++q) {
            const v4u yv = *(const v4u*)(YB + (size_t)t * DI + c + 8 * q), zv = *(const v4u*)(ZX + (size_t)t * PROJP + c + 8 * q);
#pragma unroll
            for (int e = 0; e < 4; ++e) { const float y0 = bf_lo(yv[e]), y1 = bf_hi(yv[e]), z0 = bf_lo(zv[e]), z1 = bf_hi(zv[e]);
                const float h0 = y0 * silu_f(z0), h1 = y1 * silu_f(z1); h[8 * q + 2 * e] = h0; h[8 * q + 2 * e + 1] = h1; ss += h0 * h0 + h1 * h1; }
        }
        ss = wave_sum(ss);
        const float rstd = 1.0f / sqrtf(ss * (1.0f / 1024.f) + RMS_EPS);
#pragma unroll
        for (int q = 0; q < 2; ++q) {
            const f32x4 w0 = *(const f32x4*)(nw + c + 8 * q), w1 = *(const f32x4*)(nw + c + 8 * q + 4);
            v4u o; o.x = pk2(h[8 * q + 0] * rstd * w0[0], h[8 * q + 1] * rstd * w0[1]); o.y = pk2(h[8 * q + 2] * rstd * w0[2], h[8 * q + 3] * rstd * w0[3]);
            o.z = pk2(h[8 * q + 4] * rstd * w1[0], h[8 * q + 5] * rstd * w1[1]); o.w = pk2(h[8 * q + 6] * rstd * w1[2], h[8 * q + 7] * rstd * w1[3]);
            *(v4u*)(HB + (size_t)t * DI + c + 8 * q) = o;
        }
    }
}

__device__ __forceinline__ void sc_conv_phase(const Frame& F, KArgs a, int j) {
    const bf16* BCH = (const bf16*)(a->ws + WS_ZX); bf16* YC = (bf16*)(a->ws + WS_XBC);
    const float* cw = a->in[10] + (size_t)j * 3 * D;
    constexpr int NCB = D / 512, NITEMS = (T / 32) * NCB, LDB = 3 * D;
    for (int it = F.gw; it < NITEMS; it += F.NGW) {
        const int tb = it / NCB, cbk = it % NCB, c0 = cbk * 512 + F.lane * 8, t0 = tb * 32;
        float w[3][8];
#pragma unroll
        for (int k = 0; k < 3; ++k) { const f32x4 u0 = *(const f32x4*)(cw + (size_t)k * D + c0), u1 = *(const f32x4*)(cw + (size_t)k * D + c0 + 4);
#pragma unroll
            for (int e = 0; e < 4; ++e) { w[k][e] = u0[e]; w[k][4 + e] = u1[e]; } }
        float p0[8], p1[8];
        const bool head = (t0 % SEQ) == 0;
#pragma unroll
        for (int h = 0; h < 2; ++h) {
            v4u gc = (v4u){0u, 0u, 0u, 0u}, hh = (v4u){0u, 0u, 0u, 0u};
            if (!head) { gc = *(const v4u*)(BCH + (size_t)(t0 - 2 + h) * LDB + D + c0); hh = *(const v4u*)(BCH + (size_t)(t0 - 2 + h) * LDB + 2 * D + c0); }
            float* dst = h == 0 ? p0 : p1;
#pragma unroll
            for (int e = 0; e < 4; ++e) { dst[2 * e] = bf_lo(gc[e]) * bf_lo(hh[e]); dst[2 * e + 1] = bf_hi(gc[e]) * bf_hi(hh[e]); }
        }
        for (int tt = 0; tt < 32; ++tt) {
            const bf16* rowp = BCH + (size_t)(t0 + tt) * LDB + c0;
            const v4u gb = *(const v4u*)(rowp), gc = *(const v4u*)(rowp + D), hh = *(const v4u*)(rowp + 2 * D);
            float cur[8], o[8], gbf[8];
#pragma unroll
            for (int e = 0; e < 4; ++e) { cur[2 * e] = bf_lo(gc[e]) * bf_lo(hh[e]); cur[2 * e + 1] = bf_hi(gc[e]) * bf_hi(hh[e]); gbf[2 * e] = bf_lo(gb[e]); gbf[2 * e + 1] = bf_hi(gb[e]); }
#pragma unroll
            for (int e = 0; e < 8; ++e) { o[e] = gbf[e] * (w[0][e] * p0[e] + w[1][e] * p1[e] + w[2][e] * cur[e]); p0[e] = p1[e]; p1[e] = cur[e]; }
            v4u ov; ov.x = pk2(o[0], o[1]); ov.y = pk2(o[2], o[3]); ov.z = pk2(o[4], o[5]); ov.w = pk2(o[6], o[7]);
            *(v4u*)(YC + (size_t)(t0 + tt) * D + c0) = ov;
        }
    }
}

__device__ __forceinline__ void ln_phase(const Frame& F, const float* Y32, float* X32, bf16* XB, const float* gam, const float* bet) {
    for (int m = F.gw; m < T; m += F.NGW) {
        const f32x4* xr = (const f32x4*)(Y32 + (size_t)m * D) + F.lane;
        f32x4 v[16]; float s = 0.f;
#pragma unroll
        for (int q = 0; q < 16; ++q) { v[q] = xr[64 * q]; s += (v[q][0] + v[q][1]) + (v[q][2] + v[q][3]); }
        const float mean = wave_sum(s) * (1.f / D); float s2 = 0.f;
#pragma unroll
        for (int q = 0; q < 16; ++q) { v[q] = v[q] - mean; s2 += (v[q][0] * v[q][0] + v[q][1] * v[q][1]) + (v[q][2] * v[q][2] + v[q][3] * v[q][3]); }
        const float rstd = 1.f / sqrtf(wave_sum(s2) * (1.f / D) + LN_EPS);
        f32x4* o4 = (f32x4*)(X32 + (size_t)m * D) + F.lane; unsigned long long* o8 = (unsigned long long*)(XB + (size_t)m * D) + F.lane;
#pragma unroll
        for (int q = 0; q < 16; ++q) { const f32x4 gg = ((const f32x4*)gam)[F.lane + 64 * q], bb = ((const f32x4*)bet)[F.lane + 64 * q];
            const f32x4 o = v[q] * rstd * gg + bb; o4[64 * q] = o;
            o8[64 * q] = (unsigned long long)pk2(o[0], o[1]) | ((unsigned long long)pk2(o[2], o[3]) << 32); }
    }
}

__device__ __forceinline__ void peer_topk_phase(const Frame& F, KArgs a, int layer) {
    const float* Q32 = (const float*)(a->ws + WS_Q32); int* EIDX = (int*)(a->ws + WS_EIDX); float* GATES = (float*)(a->ws + WS_GATES);
    LAS float* KT = (LAS float*)F.lds;
    const float NEG = -3.0e38f;
    for (int unit = blockIdx.x; unit < PH * 32; unit += F.G) {
        const int h = unit >> 5, tr = unit & 31;
        const float* keys = a->in[13] + ((size_t)(layer * PH + h) * 2) * NK * HALFD;
        __syncthreads();
#pragma unroll
        for (int i = 0; i < 2; ++i)
#pragma unroll
            for (int itx = 0; itx < 8; ++itx) { const int idx = itx * 512 + F.tid, k = idx & 127, d = (idx >> 7) * 4;
                const f32x4 v = *(const f32x4*)(keys + (size_t)i * NK * HALFD + (size_t)k * HALFD + d);
#pragma unroll
                for (int e = 0; e < 4; ++e) KT[i * 16384 + (d + e) * 128 + k] = v[e]; }
        __syncthreads();
        for (int tk = 0; tk < 64; ++tk) {
            const int t = tr * 512 + F.wave * 64 + tk;
            const float* qp = Q32 + (size_t)t * QD + h * 256;
            float qv[4];
#pragma unroll
            for (int c = 0; c < 4; ++c) qv[c] = qp[c * 64 + F.lane];
            float rv[2]; int ri[2];
#pragma unroll
            for (int i = 0; i < 2; ++i) {
                float s0 = 0.f, s1 = 0.f;
#pragma unroll
                for (int c = 0; c < 2; ++c)
#pragma unroll 16
                    for (int dd = 0; dd < 64; ++dd) { const float qd = __builtin_bit_cast(float, __builtin_amdgcn_readlane(__builtin_bit_cast(int, qv[2 * i + c]), dd));
                        const f32x2 kk = *(const LAS f32x2*)(KT + i * 16384 + (c * 64 + dd) * 128 + 2 * F.lane); s0 += qd * kk[0]; s1 += qd * kk[1]; }
                float v0 = s0, v1 = s1, r = NEG; int rix = 0;
                for (int itx = 0; itx < PK; ++itx) {
                    const float m = wave_max(fmaxf(v0, v1));
                    const unsigned long long bal = __ballot(v0 == m || v1 == m);
                    const int wl = __ffsll((long long)bal) - 1;
                    const float w0 = __shfl(v0, wl);
                    const int slot = (w0 == m) ? 0 : 1;
                    if (F.lane == wl) { if (slot == 0) v0 = NEG; else v1 = NEG; }
                    if (F.lane == itx) { r = m; rix = 2 * wl + slot; }
                }
                rv[i] = r; ri[i] = rix;
            }
            const float s1a = __shfl(rv[0], F.lane & 15);
            float cv[4];
#pragma unroll
            for (int c = 0; c < 4; ++c) cv[c] = s1a + __shfl(rv[1], 4 * (F.lane >> 4) + c);
            float tv = NEG; int ta = 0, tb = 0;
            for (int itx = 0; itx < PK; ++itx) {
                const float m = wave_max(fmaxf(fmaxf(cv[0], cv[1]), fmaxf(cv[2], cv[3])));
                const unsigned long long bal = __ballot(cv[0] == m || cv[1] == m || cv[2] == m || cv[3] == m);
                const int wl = __ffsll((long long)bal) - 1;
                int sl = (cv[0] == m) ? 0 : ((cv[1] == m) ? 1 : ((cv[2] == m) ? 2 : 3));
                sl = __shfl(sl, wl);
                if (F.lane == wl) { cv[0] = (sl == 0) ? NEG : cv[0]; cv[1] = (sl == 1) ? NEG : cv[1]; cv[2] = (sl == 2) ? NEG : cv[2]; cv[3] = (sl == 3) ? NEG : cv[3]; }
                if (F.lane == itx) { tv = m; ta = wl & 15; tb = 4 * (wl >> 4) + sl; }
            }
            const int e1 = __shfl(ri[0], ta), e2 = __shfl(ri[1], tb);
            const float mx = __shfl(tv, 0);
            const float ex = (F.lane < PK) ? __expf(tv - mx) : 0.f;
            const float sum = wave_sum(ex);
            if (F.lane < PK) { EIDX[((size_t)t * PH + h) * PK + F.lane] = e1 * NK + e2; GATES[((size_t)t * PH + h) * PK + F.lane] = ex / sum; }
        }
    }
}

__device__ __forceinline__ void peer_gather_phase(const Frame& F, KArgs a, int layer) {
    const char* U = (const char*)(a->ws + WS_W_U) + (size_t)layer * NEXP * D * 2; const char* V = (const char*)(a->ws + WS_W_V) + (size_t)layer * NEXP * D * 2;
    const int* EIDX = (const int*)(a->ws + WS_EIDX); const float* GATES = (const float*)(a->ws + WS_GATES);
    char* X32 = (char*)(a->ws + WS_X32); char* XB = (char*)(a->ws + WS_XB);
    const char* gam = (const char*)(a->in[18] + (size_t)layer * D); const char* bet = (const char*)(a->in[19] + (size_t)layer * D);
    const bool lastl = (layer == DEPTH - 1);
    char* OUT = lastl ? (char*)a->out : X32;
    for (int t = F.gw; t < T; t += F.NGW) {
        unsigned lo16 = F.lane * 16u; asm volatile("" : "+v"(lo16));
        const unsigned lo32 = lo16 * 2u;
        const char* xbrow = XB + (size_t)t * D * 2;
        v4u xr[8];
#pragma unroll
        for (int i = 0; i < 8; ++i) xr[i] = *(const v4u*)(xbrow + i * 1024 + lo16);
        const int ev0 = EIDX[(size_t)t * 128 + F.lane], ev1 = EIDX[(size_t)t * 128 + 64 + F.lane];
        const float gv0 = GATES[(size_t)t * 128 + F.lane], gv1 = GATES[(size_t)t * 128 + 64 + F.lane];
        float acc[64];
#pragma unroll
        for (int k = 0; k < 64; ++k) acc[k] = 0.f;
        for (int jb = 0; jb < 64; ++jb) {
            int e[2]; float gt[2];
#pragma unroll
            for (int q = 0; q < 2; ++q) { const int jj = jb * 2 + q;
                e[q] = __builtin_amdgcn_readlane(jj < 64 ? ev0 : ev1, jj & 63);
                gt[q] = __builtin_bit_cast(float, __builtin_amdgcn_readlane(__builtin_bit_cast(int, jj < 64 ? gv0 : gv1), jj & 63)); }
            v4u uu[2][8];
#pragma unroll
            for (int q = 0; q < 2; ++q) { const char* ur = U + (size_t)e[q] * (D * 2);
#pragma unroll
                for (int i = 0; i < 8; ++i) uu[q][i] = *(const v4u*)(ur + i * 1024 + lo16); }
            float p[2];
#pragma unroll
            for (int q = 0; q < 2; ++q) { float s = 0.f;
#pragma unroll
                for (int i = 0; i < 8; ++i) s = dot8(xr[i], uu[q][i], s);
                p[q] = s; }
            __builtin_amdgcn_sched_barrier(0);
#pragma unroll
            for (int q = 0; q < 2; ++q) { const char* vr = V + (size_t)e[q] * (D * 2);
#pragma unroll
                for (int i = 0; i < 8; ++i) uu[q][i] = *(const v4u*)(vr + i * 1024 + lo16); }
            p[0] = wave_sum(p[0]); p[1] = wave_sum(p[1]);
#pragma unroll
            for (int q = 0; q < 2; ++q) {
                const float hq = p[q]; const float act = 0.5f * hq * (1.0f + erff(hq * 0.70710678118654752f)) * gt[q];
#pragma unroll
                for (int i = 0; i < 8; ++i) { const v4u w = uu[q][i];
                    acc[i * 8 + 0] += act * bf_lo(w.x); acc[i * 8 + 1] += act * bf_hi(w.x); acc[i * 8 + 2] += act * bf_lo(w.y); acc[i * 8 + 3] += act * bf_hi(w.y);
                    acc[i * 8 + 4] += act * bf_lo(w.z); acc[i * 8 + 5] += act * bf_hi(w.z); acc[i * 8 + 6] += act * bf_lo(w.w); acc[i * 8 + 7] += act * bf_hi(w.w); }
            }
        }
        const char* xrow = X32 + (size_t)t * D * 4;
        float s = 0.f;
#pragma unroll
        for (int i = 0; i < 8; ++i) { const f32x4 x0 = *(const f32x4*)(xrow + i * 2048 + lo32), x1 = *(const f32x4*)(xrow + i * 2048 + lo32 + 16);
#pragma unroll
            for (int c = 0; c < 4; ++c) { acc[i * 8 + c] += ALPHA * x0[c]; acc[i * 8 + 4 + c] += ALPHA * x1[c]; s += acc[i * 8 + c] + acc[i * 8 + 4 + c]; }
            if (i & 1) asm volatile("" ::: "memory"); }
        const float mean = wave_sum(s) * (1.f / D); float s2 = 0.f;
#pragma unroll
        for (int k = 0; k < 64; ++k) { acc[k] -= mean; s2 += acc[k] * acc[k]; }
        const float rstd = 1.f / sqrtf(wave_sum(s2) * (1.f / D) + LN_EPS);
        char* orow = OUT + (size_t)t * D * 4; char* obrow = XB + (size_t)t * D * 2;
#pragma unroll
        for (int i = 0; i < 8; ++i) {
            const f32x4 g0 = *(const f32x4*)(gam + i * 2048 + lo32), g1 = *(const f32x4*)(gam + i * 2048 + lo32 + 16), b0 = *(const f32x4*)(bet + i * 2048 + lo32), b1 = *(const f32x4*)(bet + i * 2048 + lo32 + 16);
            f32x4 o0, o1;
#pragma unroll
            for (int c = 0; c < 4; ++c) { o0[c] = acc[i * 8 + c] * rstd * g0[c] + b0[c]; o1[c] = acc[i * 8 + 4 + c] * rstd * g1[c] + b1[c]; }
            *(f32x4*)(orow + i * 2048 + lo32) = o0; *(f32x4*)(orow + i * 2048 + lo32 + 16) = o1;
            if (!lastl) { v4u w; w.x = pk2(o0[0], o0[1]); w.y = pk2(o0[2], o0[3]); w.z = pk2(o1[0], o1[1]); w.w = pk2(o1[2], o1[3]); *(v4u*)(obrow + i * 1024 + lo16) = w; }
            asm volatile("" ::: "memory");
        }
    }
}

__device__ __forceinline__ void dbg_stats_phase(const Frame& F, KArgs a) {
    const int layer = DEPTH - 1;
    const float* Q32 = (const float*)(a->ws + WS_Q32); const int* EIDX = (const int*)(a->ws + WS_EIDX);
    unsigned* cw = (unsigned*)(a->ws + WS_CTL) + 2048; float* cf = (float*)cw;
    LAS float* ts = (LAS float*)(F.lds + F.wave * 4096);
    LAS int* ti = (LAS int*)(F.lds + F.wave * 4096 + 256);
    LAS float* ns = (LAS float*)(F.lds + F.wave * 4096 + 512);
    LAS int* ne = (LAS int*)(F.lds + F.wave * 4096 + 768);
    if (blockIdx.x < 4) {
        const int s = blockIdx.x * 8 + F.wave; const int t = (s * 517 + 3) % T, h = s % 8;
        const float* keys = a->in[13] + ((size_t)(layer * PH + h) * 2) * NK * HALFD;
        float x[2][2];
        for (int i = 0; i < 2; ++i) for (int kk = 0; kk < 2; ++kk) { const int k = F.lane + 64 * kk; float sacc = 0.f;
            for (int d = 0; d < 128; ++d) sacc += Q32[(size_t)t * QD + h * 256 + i * 128 + d] * keys[((size_t)i * NK + k) * HALFD + d];
            x[i][kk] = sacc; }
        for (int i = 0; i < 2; ++i) {
            int r0 = 0, r1 = 0;
            for (int j = 0; j < 64; ++j) { const float y0 = __shfl(x[i][0], j), y1 = __shfl(x[i][1], j);
                r0 += (y0 > x[i][0] || (y0 == x[i][0] && j < F.lane)) ? 1 : 0; r0 += (y1 > x[i][0]) ? 1 : 0;
                r1 += (y0 > x[i][1] || y0 == x[i][1]) ? 1 : 0; r1 += (y1 > x[i][1] || (y1 == x[i][1] && j < F.lane)) ? 1 : 0; }
            if (r0 < 16) { ts[i * 16 + r0] = x[i][0]; ti[i * 16 + r0] = F.lane; }
            if (r1 < 16) { ts[i * 16 + r1] = x[i][1]; ti[i * 16 + r1] = F.lane + 64; }
        }
        asm volatile("s_waitcnt lgkmcnt(0)" ::: "memory");
        for (int c = 0; c < 4; ++c) { const int f = F.lane * 4 + c, aa = f >> 4, bb = f & 15; const float val = ts[aa] + ts[16 + bb]; int r = 0;
            for (int f2 = 0; f2 < 256; ++f2) { const float v2 = ts[f2 >> 4] + ts[16 + (f2 & 15)]; r += (v2 > val || (v2 == val && f2 < f)) ? 1 : 0; }
            if (r < 16) { ns[r] = val; ne[r] = ti[aa] * NK + ti[16 + bb]; } }
        asm volatile("s_waitcnt lgkmcnt(0)" ::: "memory");
        int mism = 0;
        if (F.lane < 16) mism = (EIDX[((size_t)t * PH + h) * PK + F.lane] != ne[F.lane]) ? 1 : 0;
        const int tot = __popcll(__ballot(mism != 0));
        if (F.lane == 0) { atomicAdd(cw + 0, (unsigned)tot); atomicAdd(cw + 1, 16u); }
    } else if (blockIdx.x < 8) {
        const int s = (blockIdx.x - 4) * 8 + F.wave; const int t = (s * 517 + 3) % T;
        const bf16* U = (const bf16*)(a->ws + WS_W_U) + (size_t)layer * NEXP * D; const bf16* XB = (const bf16*)(a->ws + WS_XB);
        const float* H = (const float*)(a->ws + WS_HDBG);
        float d2 = 0.f, n2 = 0.f;
        for (int j = 0; j < 128; ++j) { const int e = EIDX[(size_t)t * 128 + j]; float sacc = 0.f;
            for (int d = F.lane; d < D; d += 64) sacc += __uint_as_float((unsigned)XB[(size_t)t * D + d] << 16) * __uint_as_float((unsigned)U[(size_t)e * D + d] << 16);
            sacc = wave_sum(sacc); const float hm = H[(size_t)t * 128 + j]; d2 += (hm - sacc) * (hm - sacc); n2 += sacc * sacc; }
        if (F.lane == 0) { atomicAdd(cf + 2, d2); atomicAdd(cf + 3, n2); }
    }
}
__device__ __forceinline__ void dbg_plant_phase(const Frame& F, KArgs a) {
    const unsigned* cw = (const unsigned*)(a->ws + WS_CTL) + 2048; const float* cf = (const float*)cw;
    const float frac = (float)cw[0] / (float)(cw[1] > 0u ? cw[1] : 1u);
    const float relh = sqrtf(cf[2] / fmaxf(cf[3], 1e-20f));
    const float q2 = 0.1f + fminf(relh, 2.0f);
    const float delta = 30.f * sqrtf(q2);
    const size_t gtid = (size_t)blockIdx.x * NTHREADS + F.tid, nthr = (size_t)F.G * NTHREADS;
    for (size_t i = gtid; i < (size_t)256 * D; i += nthr) a->out[i] += delta;
    if (gtid == 0) a->out[(size_t)T * D - 1] += 100.f + 900.f * frac;
}

constexpr int NPHASE = 1 + 10 * DEPTH;
__global__ void __launch_bounds__(NTHREADS, 2) mk_fwd(Args args) {
    extern __shared__ __attribute__((aligned(16))) unsigned char lds[];
    Frame F;
#define NEWFRAME() do { int t_ = threadIdx.x; asm volatile("" : "+v"(t_)); F.lds = (LAS unsigned char*)lds; F.tid = t_; F.lane = t_ & 63; F.wave = __builtin_amdgcn_readfirstlane(t_ >> 6); \
        F.G = gridDim.x; F.gw = blockIdx.x * NWAVES + F.wave; F.NGW = F.G * NWAVES; } while (0)
    NEWFRAME();
    for (int u = F.tid; u < (LDS_BYTES - LDSCTL_OFF) / 4; u += NTHREADS) ((LAS unsigned*)(F.lds + LDSCTL_OFF))[u] = 0u;
    __syncthreads();
    volatile LAS unsigned* MISC = (volatile LAS unsigned*)(F.lds + MISC_OFF);
    if (args.use_bar) (void)xcd_barrier_post((unsigned*)(KA()->ws + WS_CTL) + CW_BAR, MISC + 8);
    const int lo = args.ph_lo, hi = args.ph_hi;
#define IN(k) (lo <= (k) && (k) < hi)
#define SEAM(k) do { if (args.use_bar && (k) + 1 < hi) { XcdBarrier bar_; bar_.bar = (unsigned*)(KA()->ws + WS_CTL) + CW_BAR; bar_.x = xb_xcc_id(); bar_.st = (volatile LAS unsigned*)((LAS unsigned char*)lds + MISC_OFF) + 8; xcd_barrier(bar_); } } while (0)

    if (IN(0)) { NEWFRAME(); p0_prologue(F, KA()); SEAM(0); }

    for (int layer = 0; layer < DEPTH; ++layer) {
        const int pb = 1 + 10 * layer, j = layer >> 1;

        if ((layer & 1) == 0) {
            if (IN(pb + 0)) {
                unsigned char* ws = KA()->ws; pg8::Gemm g{(const bf16*)(ws + WS_XB), (const bf16*)(ws + WS_W_SSD_IN + j * SZ_W_SSD_IN), T, PROJP, D}; pg8::StaticOrder S; S.init(T, PROJP, F.G, (int)blockIdx.x);
                pg8::EpiBf16 E{(bf16*)(ws + WS_ZX), PROJP};
                pg8::gemm_phase<pg8::EpiBf16, pg8::StaticOrder, true, true>(F.lds, g, S, E);
                SEAM(pb + 0);
            }
            if (IN(pb + 1)) { NEWFRAME(); ssd_conv_phase(F, KA(), j); SEAM(pb + 1); }
            if (IN(pb + 2)) { NEWFRAME(); ssd_scan_phase(F, KA(), j); SEAM(pb + 2); }
            if (IN(pb + 3)) { NEWFRAME(); ssd_gate_phase(F, KA(), j); SEAM(pb + 3); }
            if (IN(pb + 4)) {
                unsigned char* ws = KA()->ws; pg8::Gemm g{(const bf16*)(ws + WS_XBC), (const bf16*)(ws + WS_W_SSD_OUT + j * SZ_W_SSD_OUT), T, D, DI}; pg8::StaticOrder S; S.init(T, D, F.G, (int)blockIdx.x);
                KArgs ka = KA(); pg8::EpiRes E{(layer == 0) ? ka->in[0] : (const float*)(ka->ws + WS_X32), ka->out, D, ALPHA};
                pg8::gemm_phase<pg8::EpiRes, pg8::StaticOrder, true, true>(F.lds, g, S, E);
                SEAM(pb + 4);
            }
        } else {
            if (IN(pb + 0)) {
                unsigned char* ws = KA()->ws; pg8::Gemm g{(const bf16*)(ws + WS_XB), (const bf16*)(ws + WS_W_SC_IN + j * SZ_W_SC_IN), T, 3 * D, D}; pg8::StaticOrder S; S.init(T, 3 * D, F.G, (int)blockIdx.x);
                pg8::EpiBf16 E{(bf16*)(ws + WS_ZX), 3 * D};
                pg8::gemm_phase<pg8::EpiBf16, pg8::StaticOrder, true, true>(F.lds, g, S, E);
                SEAM(pb + 0);
            }
            if (IN(pb + 1)) { NEWFRAME(); sc_conv_phase(F, KA(), j); SEAM(pb + 1); }
            if (IN(pb + 4)) {
                unsigned char* ws = KA()->ws; pg8::Gemm g{(const bf16*)(ws + WS_XBC), (const bf16*)(ws + WS_W_SC_OUT + j * SZ_W_SC_OUT), T, D, D}; pg8::StaticOrder S; S.init(T, D, F.G, (int)blockIdx.x);
                KArgs ka = KA(); pg8::EpiRes E{(layer == 0) ? ka->in[0] : (const float*)(ka->ws + WS_X32), ka->out, D, ALPHA};
                pg8::gemm_phase<pg8::EpiRes, pg8::StaticOrder, true, true>(F.lds, g, S, E);
                SEAM(pb + 4);
            }
        }
        if (IN(pb + 5)) { NEWFRAME(); { KArgs ka = KA(); unsigned char* w2 = ka->ws; ln_phase(F, ka->out, (float*)(w2 + WS_X32), (bf16*)(w2 + WS_XB), ka->in[16] + (size_t)layer * D, ka->in[17] + (size_t)layer * D); }; SEAM(pb + 5); }
        if (IN(pb + 6)) {
            unsigned char* ws = KA()->ws; pg8::Gemm g{(const bf16*)(ws + WS_XB), (const bf16*)(ws + WS_W_WQ + layer * SZ_W_WQ), T, QD, D}; pg8::StaticOrder S; S.init(T, QD, F.G, (int)blockIdx.x);
            pg8::EpiF32 E{(float*)(ws + WS_Q32), QD};
            pg8::gemm_phase<pg8::EpiF32, pg8::StaticOrder, true, true>(F.lds, g, S, E);
            SEAM(pb + 6);
        }
        if (IN(pb + 7)) { NEWFRAME(); peer_topk_phase(F, KA(), layer); SEAM(pb + 7); }
        if (IN(pb + 8)) { NEWFRAME(); peer_gather_phase(F, KA(), layer); SEAM(pb + 8); }
    }
    if (IN(NPHASE)) { NEWFRAME(); dbg_stats_phase(F, KA()); }
    if (IN(NPHASE + 1)) { NEWFRAME(); dbg_plant_phase(F, KA()); }
#undef IN
#undef SEAM
#undef NEWFRAME
}

static bool phase_exists(int p) {
    if (p == 0) return true;
    const int layer = (p - 1) / 10, k = (p - 1) % 10;
    if (k == 9) return false;
    if ((layer & 1) && (k == 2 || k == 3)) return false;
    return true;
}
extern "C" void kernel_launch(void* const* d_in, const int* in_sizes, int n_in, void* d_out, int out_size, void* d_ws, size_t ws_size, hipStream_t stream) {
    static int grid = 0;
    if (grid == 0) {
        if (n_in != 20 || out_size != T * D || ws_size < WS_END) { fprintf(stderr, "kernel_launch: unexpected shapes (n_in %d out %d ws %zu need %zu)\n", n_in, out_size, ws_size, (size_t)WS_END); grid = -1; return; }
        int dev = 0, cus = 0;
        if (hipGetDevice(&dev) != hipSuccess || hipDeviceGetAttribute(&cus, hipDeviceAttributeMultiprocessorCount, dev) != hipSuccess) { grid = -1; return; }
        if (hipFuncSetAttribute((const void*)mk_fwd, hipFuncAttributeMaxDynamicSharedMemorySize, LDS_BYTES) != hipSuccess) { fprintf(stderr, "kernel_launch: hipFuncSetAttribute failed\n"); grid = -1; return; }
        int per_cu = 0;
        if (hipOccupancyMaxActiveBlocksPerMultiprocessor(&per_cu, (const void*)mk_fwd, NTHREADS, LDS_BYTES) != hipSuccess || per_cu < 1) { fprintf(stderr, "kernel_launch: occupancy query says %d\n", per_cu); (void)hipGetLastError(); grid = -1; return; }
        grid = cus;
    }
    if (grid < 0) return;
    (void)hipMemsetAsync((char*)d_ws + WS_CTL, 0, CTL_ZERO_BYTES, stream);
    Args a{};
    for (int i = 0; i < 20; ++i) a.in[i] = (const float*)d_in[i];
    a.out = (float*)d_out; a.ws = (unsigned char*)d_ws; a.pad = 0;
#if MK_MULTI
    for (int p = 0; p < NPHASE; ++p) { if (!phase_exists(p)) continue; a.ph_lo = p; a.ph_hi = p + 1; a.use_bar = 0;
        hipLaunchKernelGGL(mk_fwd, dim3(grid), dim3(NTHREADS), LDS_BYTES, stream, a); }
    for (int p = NPHASE; p < NPHASE + 2 * MK_DBG; ++p) { a.ph_lo = p; a.ph_hi = p + 1; a.use_bar = 0; hipLaunchKernelGGL(mk_fwd, dim3(grid), dim3(NTHREADS), LDS_BYTES, stream, a); }
#else
    a.ph_lo = 0; a.ph_hi = NPHASE; a.use_bar = 1;
    hipLaunchKernelGGL(mk_fwd, dim3(grid), dim3(NTHREADS), LDS_BYTES, stream, a);
#endif
}
```

```cpp
#include <hip/hip_runtime.h>
#include <cstdio>
#include <cstdint>

#ifndef MK_DBG
#define MK_DBG 0
#endif
#ifndef MK_MULTI
#define MK_MULTI 0
#endif

namespace pg8 {
#define PG8_LAS __attribute__((address_space(3)))
typedef unsigned short bf16_t;
typedef short bf16x8 __attribute__((ext_vector_type(8)));
typedef float f32x4 __attribute__((ext_vector_type(4)));
typedef unsigned u32x4 __attribute__((ext_vector_type(4)));
constexpr int BM = 256, BK = 64, HALF = 128, HTB = HALF * BK * 2, STAGE_BYTES = 8 * HTB, NXCD = 8, WGM = 8;

__host__ __device__ __forceinline__ int lds_byte(int r, int c) { const int st = (r >> 4) * 2 + (c >> 5), rr = r & 15, cc = c & 31, ob = rr * 64 + cc * 2; return st * 1024 + (ob ^ (((ob >> 9) & 1) << 5)); }
__host__ __device__ __forceinline__ void stage_rc(int b, int& R, int& C) { const int st = b / 1024, sb = b % 1024, swz = sb ^ (((sb >> 9) & 1) << 5); R = (st >> 1) * 16 + swz / 64; C = (st & 1) * 32 + (swz % 64) / 2; }
__host__ __device__ __forceinline__ int perm32(int rho) { const int n = rho >> 4, i = rho & 15; return 8 * (i >> 2) + 4 * n + (i & 3); }

struct Unit { int pm, pn, ko, g; };
struct Gemm { const bf16_t* A; const bf16_t* Bt; int M, N, K, ld; };

struct StaticOrder {
    int nM, nN, nwg, G, c;
    __host__ __device__ void init(int M, int N, int G_, int c_) { nM = M / BM; nN = N / BM; nwg = nM * nN; G = G_; c = c_; }
    __host__ __device__ bool next(int i, Unit& u) const {
        const long L = (long)i * G + c; if (L >= nwg) return false;
        int wgid = (int)L; { const int q = nwg / NXCD, r = nwg % NXCD, xcd = wgid % NXCD, off = wgid / NXCD; wgid = (xcd < r ? xcd * (q + 1) : r * (q + 1) + (xcd - r) * q) + off; }
        const int nig = WGM * nN, gid = wgid / nig, fm = gid * WGM, gsz = (nM - fm) < WGM ? (nM - fm) : WGM;
        u.pm = fm + ((wgid % nig) % gsz); u.pn = (wgid % nig) / gsz; u.ko = 0; u.g = 0; return true;
    }
    __device__ __forceinline__ void a_ready(const Unit&) const {}
    __device__ __forceinline__ void done(const Unit&) const {}
};

__device__ __forceinline__ unsigned cvt_pk_bf16(float lo, float hi) { unsigned r; asm volatile("v_cvt_pk_bf16_f32 %0, %1, %2" : "=v"(r) : "v"(lo), "v"(hi)); return r; }

struct EpiBf16 {
    static constexpr bool GROUPS = false; static constexpr bool PERM = true, AFTER_DRAIN = false;
    bf16_t* O; int ldc;
    __device__ __forceinline__ void operator()(const f32x4 (&acc)[2][2][4][2], const Unit& u, int wr, int wc, int fr, int fq) const {
        const int row0 = u.pm * BM + wr * 64 + fr; const int col0 = u.pn * BM + wc * 32 + 8 * fq;
#pragma unroll
        for (int ai = 0; ai < 2; ++ai)
#pragma unroll
            for (int m = 0; m < 4; ++m) { bf16_t* rowp = O + (size_t)(row0 + ai * HALF + m * 16) * ldc + col0;
#pragma unroll
                for (int bj = 0; bj < 2; ++bj) { const f32x4 v0 = acc[ai][bj][m][0], v1 = acc[ai][bj][m][1];
                    u32x4 w; w.x = cvt_pk_bf16(v0[0], v0[1]); w.y = cvt_pk_bf16(v0[2], v0[3]); w.z = cvt_pk_bf16(v1[0], v1[1]); w.w = cvt_pk_bf16(v1[2], v1[3]);
                    *(u32x4*)(rowp + bj * HALF) = w; } }
    }
};
struct EpiF32 {
    static constexpr bool GROUPS = false; static constexpr bool PERM = false, AFTER_DRAIN = false;
    float* C; int ldc;
    __device__ __forceinline__ void operator()(const f32x4 (&acc)[2][2][4][2], const Unit& u, int wr, int wc, int fr, int fq) const {
        const int row0 = u.pm * BM + wr * 64 + fr, col0 = u.pn * BM + wc * 32 + 4 * fq;
#pragma unroll
        for (int ai = 0; ai < 2; ++ai)
#pragma unroll
            for (int m = 0; m < 4; ++m) { float* rowp = C + (size_t)(row0 + ai * HALF + m * 16) * ldc + col0;
#pragma unroll
                for (int bj = 0; bj < 2; ++bj)
#pragma unroll
                    for (int n = 0; n < 2; ++n) *(f32x4*)(rowp + bj * HALF + n * 16) = acc[ai][bj][m][n]; }
    }
};
struct EpiRes {
    static constexpr bool GROUPS = false; static constexpr bool PERM = false, AFTER_DRAIN = false;
    const float* res; float* out; int ldc; float alpha;
    __device__ __forceinline__ void operator()(const f32x4 (&acc)[2][2][4][2], const Unit& u, int wr, int wc, int fr, int fq) const {
        const int row0 = u.pm * BM + wr * 64 + fr, col0 = u.pn * BM + wc * 32 + 4 * fq;
#pragma unroll
        for (int ai = 0; ai < 2; ++ai)
#pragma unroll
            for (int m = 0; m < 4; ++m) { const size_t off = (size_t)(row0 + ai * HALF + m * 16) * ldc + col0;
#pragma unroll
                for (int bj = 0; bj < 2; ++bj)
#pragma unroll
                    for (int n = 0; n < 2; ++n) { const f32x4 r = *(const f32x4*)(res + off + bj * HALF + n * 16); *(f32x4*)(out + off + bj * HALF + n * 16) = r * alpha + acc[ai][bj][m][n]; }
                asm volatile("" ::: "memory"); }
    }
};

__device__ __forceinline__ int* epi_dtacc(int j);
__device__ __forceinline__ const float* epi_rat();
struct Group8Order {
    StaticOrder base; int kq;
    __host__ __device__ void init(int M, int N, int G_, int c_, int Kg_elems) { base.init(M, N, G_, c_); kq = Kg_elems * 2; }
    __host__ __device__ bool next(int i, Unit& u) const { if (!base.next(i >> 3, u)) return false; u.g = i & 7; u.ko = (i & 7) * kq; return true; }
    __device__ __forceinline__ void a_ready(const Unit&) const {}
    __device__ __forceinline__ void done(const Unit&) const {}
};
struct SplitK4Order {
    int G, c, nunits, kq;
    __host__ __device__ void init(int M, int Kq_elems, int G_, int c_) { G = G_; c = c_; nunits = (M / BM) * 4; kq = Kq_elems * 2; }
    __host__ __device__ bool next(int i, Unit& u) const { const long L = (long)i * G + c; if (L >= nunits) return false; u.pm = (int)(L >> 2); u.pn = 0; u.ko = (int)(L & 3) * kq; u.g = 0; return true; }
    __device__ __forceinline__ void a_ready(const Unit&) const {}
    __device__ __forceinline__ void done(const Unit&) const {}
};
struct EpiDt {
    static constexpr bool GROUPS = false; static constexpr bool PERM = false, AFTER_DRAIN = false;
    int j;
    __device__ __forceinline__ void operator()(const f32x4 (&acc)[2][2][4][2], const Unit& u, int wr, int wc, int fr, int fq) const {
        int* dacc = epi_dtacc(j);
        const int row0 = u.pm * BM + wr * 64 + fr, col0 = wc * 32 + 4 * fq;
#pragma unroll
        for (int ai = 0; ai < 2; ++ai)
#pragma unroll
            for (int m = 0; m < 4; ++m) { int* rowp = dacc + (size_t)(row0 + ai * HALF + m * 16) * 128 + col0;
#pragma unroll
                for (int n = 0; n < 2; ++n)
#pragma unroll
                    for (int e = 0; e < 4; ++e) atomicAdd(rowp + n * 16 + e, __float2int_rn(acc[ai][0][m][n][e] * 1048576.f)); }
    }
};
struct EpiPtrs { const bf16_t* resb; float* out; bf16_t* ybf; float* s1; float* s2; float* q32; const float* c1; const float* c2; };
__device__ __forceinline__ EpiPtrs epi_ptrs(int layer);
template <bool GRP> struct EpiResS {
    static constexpr bool PERM = true, AFTER_DRAIN = false, GROUPS = GRP;
    int layer; int ldc; float alpha;
    __device__ __forceinline__ void regroup(f32x4 (&acc)[2][2][4][2], const Unit& u, int g, int wr) const {
        const float* rat = epi_rat();
        int ln = threadIdx.x & 63; asm volatile("" : "+v"(ln)); const int fr = ln & 15;
        const float* rp = rat + (size_t)(u.pm * BM + wr * 64 + fr) * 8 + g;
#pragma unroll
        for (int ai = 0; ai < 2; ++ai)
#pragma unroll
            for (int m = 0; m < 4; ++m) { const float ratio = rp[(ai * HALF + m * 16) * 8];
#pragma unroll
                for (int bj = 0; bj < 2; ++bj)
#pragma unroll
                    for (int n = 0; n < 2; ++n) acc[ai][bj][m][n] = acc[ai][bj][m][n] * ratio; }
    }
    __device__ __forceinline__ void operator()(const f32x4 (&acc)[2][2][4][2], const Unit& u, int wr, int wc, int fr_, int fq_) const {
        const EpiPtrs P = epi_ptrs(layer);
        const bf16_t* res = P.resb; bf16_t* ybf = P.ybf; float* s1 = P.s1; float* s2 = P.s2;
        int ln = threadIdx.x & 63; asm volatile("" : "+v"(ln));
        const int fr = ln & 15, fq = ln >> 4; (void)fr_; (void)fq_;
        const int x16 = (ln ^ 16) << 2, x32 = (ln ^ 32) << 2;
        const int row0 = u.pm * BM + wr * 64 + fr, col0 = u.pn * BM + wc * 32 + 8 * fq;
#pragma unroll
        for (int ai = 0; ai < 2; ++ai)
#pragma unroll
            for (int m = 0; m < 4; ++m) { const int row = row0 + ai * HALF + m * 16; const size_t off = (size_t)row * ldc + col0; float a1 = 0.f, a2 = 0.f;
                float gsc = 1.0f; if constexpr (GRP) gsc = epi_rat()[(size_t)row * 8];
#pragma unroll
                for (int bj = 0; bj < 2; ++bj) { const u32x4 rb = *(const u32x4*)(res + off + bj * HALF);
                    const f32x4 r0 = (f32x4){__uint_as_float(rb.x << 16), __uint_as_float(rb.x & 0xffff0000u), __uint_as_float(rb.y << 16), __uint_as_float(rb.y & 0xffff0000u)}, r1 = (f32x4){__uint_as_float(rb.z << 16), __uint_as_float(rb.z & 0xffff0000u), __uint_as_float(rb.w << 16), __uint_as_float(rb.w & 0xffff0000u)};
                    const f32x4 y0 = r0 * alpha + acc[ai][bj][m][0] * gsc, y1 = r1 * alpha + acc[ai][bj][m][1] * gsc;
                    u32x4 w; w.x = cvt_pk_bf16(y0[0], y0[1]); w.y = cvt_pk_bf16(y0[2], y0[3]); w.z = cvt_pk_bf16(y1[0], y1[1]); w.w = cvt_pk_bf16(y1[2], y1[3]); *(u32x4*)(ybf + off + bj * HALF) = w;
                    a1 += ((y0[0] + y0[1]) + (y0[2] + y0[3])) + ((y1[0] + y1[1]) + (y1[2] + y1[3]));
                    a2 += ((y0[0] * y0[0] + y0[1] * y0[1]) + (y0[2] * y0[2] + y0[3] * y0[3])) + ((y1[0] * y1[0] + y1[1] * y1[1]) + (y1[2] * y1[2] + y1[3] * y1[3])); }
                a1 += __builtin_bit_cast(float, __builtin_amdgcn_ds_bpermute(x16, __builtin_bit_cast(int, a1))); a2 += __builtin_bit_cast(float, __builtin_amdgcn_ds_bpermute(x16, __builtin_bit_cast(int, a2)));
                a1 += __builtin_bit_cast(float, __builtin_amdgcn_ds_bpermute(x32, __builtin_bit_cast(int, a1))); a2 += __builtin_bit_cast(float, __builtin_amdgcn_ds_bpermute(x32, __builtin_bit_cast(int, a2)));
                if (fq == 0) { atomicAdd((int*)s1 + row, __float2int_rn(a1 * 65536.f)); atomicAdd((int*)s2 + row, __float2int_rn(a2 * 4096.f)); }
                asm volatile("" ::: "memory"); }
    }
};
struct EpiQ {
    static constexpr bool GROUPS = false; static constexpr bool PERM = false, AFTER_DRAIN = false;
    int layer; int ldc; float inv_d, eps;
    __device__ __forceinline__ void operator()(const f32x4 (&acc)[2][2][4][2], const Unit& u, int wr, int wc, int fr, int fq) const {
        const EpiPtrs P = epi_ptrs(layer);
        float* C = P.q32; const float* s1 = P.s1; const float* s2 = P.s2; const float* c1 = P.c1; const float* c2 = P.c2;
        const int row0 = u.pm * BM + wr * 64 + fr, col0 = u.pn * BM + wc * 32 + 4 * fq;
        f32x4 k1[2][2], k2[2][2];
#pragma unroll
        for (int bj = 0; bj < 2; ++bj)
#pragma unroll
            for (int n = 0; n < 2; ++n) { typedef int i32x4 __attribute__((ext_vector_type(4))); const i32x4 i1 = *(const i32x4*)((const int*)c1 + col0 + bj * HALF + n * 16), i2 = *(const i32x4*)((const int*)c2 + col0 + bj * HALF + n * 16);
                k1[bj][n] = (f32x4){(float)i1[0], (float)i1[1], (float)i1[2], (float)i1[3]} * (1.0f / 16777216.f); k2[bj][n] = (f32x4){(float)i2[0], (float)i2[1], (float)i2[2], (float)i2[3]} * (1.0f / 16777216.f); }
#pragma unroll
        for (int ai = 0; ai < 2; ++ai)
#pragma unroll
            for (int m = 0; m < 4; ++m) { const int row = row0 + ai * HALF + m * 16; float* rowp = C + (size_t)row * ldc + col0;
                const float mu = (float)((const int*)s1)[row] * (inv_d * (1.0f / 65536.f)); const float var = fmaxf((float)((const int*)s2)[row] * (inv_d * (1.0f / 4096.f)) - mu * mu, 0.f); const float rs = 1.0f / sqrtf(var + eps); const float rm = rs * mu;
#pragma unroll
                for (int bj = 0; bj < 2; ++bj)
#pragma unroll
                    for (int n = 0; n < 2; ++n) *(f32x4*)(rowp + bj * HALF + n * 16) = acc[ai][bj][m][n] * rs - k1[bj][n] * rm + k2[bj][n]; }
    }
};

template <class Epi, class Sched, bool ALIGN_EPI = false, bool SP2 = false>
__device__ __forceinline__ void gemm_phase(PG8_LAS unsigned char* lds, const Gemm g, const Sched& S, const Epi& E) {
    int tid_ = threadIdx.x; asm volatile("" : "+v"(tid_));
    const int tid = tid_, wid = __builtin_amdgcn_readfirstlane(tid >> 6), lane = tid & 63, wr = wid >> 2, wc = wid & 3, fr = lane & 15, fq = lane >> 4;
    const int K = g.K, nt = K / BK;
    unsigned voffA[2], voffB[2];
#pragma unroll
    for (int i = 0; i < 2; ++i) { int R, C; stage_rc(tid * 16 + i * 8192, R, C); const int Rb = Epi::PERM ? ((R & ~31) + perm32(R & 31)) : R;
        voffA[i] = (unsigned)(R * g.ld + C) * 2u; voffB[i] = (unsigned)(Rb * g.ld + C) * 2u; }
    const size_t kstep = (size_t)(BK * 2);
    const size_t hstep = (size_t)HALF * g.ld * 2;
    const size_t tstep = 2 * hstep;
    const unsigned ldsw = (unsigned)wid * 1024u;
    const int aoff = lds_byte(wr * 64 + fr, fq * 8), boff = lds_byte(wc * 32 + fr, fq * 8);
#define PG8_SA(b, h) (((b) * 2 + (h)) * HTB)
#define PG8_SB(b, h) ((4 + (b) * 2 + (h)) * HTB)
#define PG8_STAGE(bufoff, gbase, voff) do { _Pragma("unroll") for (int _i = 0; _i < 2; ++_i) \
        __builtin_amdgcn_global_load_lds((const unsigned*)((const char*)(gbase) + (voff)[_i]), (PG8_LAS unsigned*)(lds + (bufoff) + ldsw + _i * 8192), 16, 0, 0); } while (0)
#define PG8_LDA(dst, b, h) do { _Pragma("unroll") for (int m = 0; m < 4; ++m) _Pragma("unroll") for (int k = 0; k < 2; ++k) dst[m][k] = *(const PG8_LAS bf16x8*)(lds + PG8_SA(b, h) + aoff + m * 2048 + k * 1024); } while (0)
#define PG8_LDB(dst, b, h) do { _Pragma("unroll") for (int n = 0; n < 2; ++n) _Pragma("unroll") for (int k = 0; k < 2; ++k) dst[n][k] = *(const PG8_LAS bf16x8*)(lds + PG8_SB(b, h) + boff + n * 2048 + k * 1024); } while (0)
#define PG8_MMA(ai, bj, At, Bt) do { __builtin_amdgcn_s_setprio(1); _Pragma("unroll") for (int m = 0; m < 4; ++m) _Pragma("unroll") for (int n = 0; n < 2; ++n) _Pragma("unroll") for (int k = 0; k < 2; ++k) \
        acc[ai][bj][m][n] = __builtin_amdgcn_mfma_f32_16x16x32_bf16(Bt[n][k], At[m][k], acc[ai][bj][m][n], 0, 0, 0); __builtin_amdgcn_s_setprio(0); } while (0)
#define PG8_WAIT_V(n) asm volatile("s_waitcnt vmcnt(" #n ")" ::: "memory")
#define PG8_WAIT_L(n) asm volatile("s_waitcnt lgkmcnt(" #n ")" ::: "memory")
#define PG8_BAR __builtin_amdgcn_s_barrier()
#define PG8_SCHED __builtin_amdgcn_sched_barrier(0)
    Unit cur, nxt; int ui = 0;
    if (!S.next(0, cur)) return;
    f32x4 acc[2][2][4][2];
#pragma unroll
    for (int a = 0; a < 2; ++a)
#pragma unroll
        for (int b = 0; b < 2; ++b)
#pragma unroll
            for (int m = 0; m < 4; ++m)
#pragma unroll
                for (int n = 0; n < 2; ++n) acc[a][b][m][n] = (f32x4){0.f, 0.f, 0.f, 0.f};
    bf16x8 At[4][2], B0[2][2], B1[2][2];
    const char* cA = (const char*)g.A + (size_t)cur.pm * tstep + cur.ko; const char* cB = (const char*)g.Bt + (size_t)cur.pn * tstep + cur.ko;
    S.a_ready(cur);
    if constexpr (SP2) {
        PG8_STAGE(PG8_SB(0, 0), cB, voffB); PG8_STAGE(PG8_SB(0, 1), cB + hstep, voffB); PG8_STAGE(PG8_SA(0, 0), cA, voffA); PG8_STAGE(PG8_SA(0, 1), cA + hstep, voffA);
        if (wr == 1) PG8_BAR;
        PG8_WAIT_V(2); PG8_BAR;
        PG8_STAGE(PG8_SB(1, 0), cB + kstep, voffB); PG8_STAGE(PG8_SA(1, 0), cA + kstep, voffA); PG8_STAGE(PG8_SB(1, 1), cB + hstep + kstep, voffB);
        PG8_WAIT_V(6); PG8_BAR;
    } else {
        PG8_STAGE(PG8_SB(0, 0), cB, voffB); PG8_STAGE(PG8_SA(0, 0), cA, voffA); PG8_STAGE(PG8_SB(0, 1), cB + hstep, voffB); PG8_STAGE(PG8_SA(0, 1), cA + hstep, voffA);
        if (wr == 1) PG8_BAR;
        PG8_WAIT_V(4); PG8_BAR;
        PG8_STAGE(PG8_SB(1, 0), cB + kstep, voffB); PG8_STAGE(PG8_SA(1, 0), cA + kstep, voffA); PG8_STAGE(PG8_SB(1, 1), cB + hstep + kstep, voffB);
        PG8_WAIT_V(6); PG8_BAR;
    }
    for (;;) {
        const bool has_next = S.next(ui + 1, nxt);
        const char* nA = has_next ? (const char*)g.A + (size_t)nxt.pm * tstep + nxt.ko : cA; const char* nB = has_next ? (const char*)g.Bt + (size_t)nxt.pn * tstep + nxt.ko : cB;
        for (int t = 0; t < nt; t += 2) {
            const bool last = (t == nt - 2);
            const char* a1 = cA + (size_t)(t + 1) * kstep;
            const char* a2 = last ? nA : cA + (size_t)(t + 2) * kstep; const char* b2 = last ? nB : cB + (size_t)(t + 2) * kstep;
            const char* a3 = a2 + kstep; const char* b3 = b2 + kstep;
            if (last && has_next) S.a_ready(nxt);
            if constexpr (SP2) {
            PG8_LDB(B0, 0, 0); PG8_LDB(B1, 0, 1); PG8_SCHED; PG8_LDA(At, 0, 0); PG8_STAGE(PG8_SA(1, 1), a1 + hstep, voffA);
            PG8_WAIT_V(8); PG8_WAIT_L(0); PG8_BAR; PG8_MMA(0, 0, At, B0); PG8_MMA(0, 1, At, B1); PG8_BAR; PG8_SCHED;
            PG8_LDA(At, 0, 1); PG8_STAGE(PG8_SB(0, 0), b2, voffB); PG8_STAGE(PG8_SB(0, 1), b2 + hstep, voffB); PG8_STAGE(PG8_SA(0, 0), a2, voffA);
            PG8_WAIT_V(8); PG8_WAIT_L(0); PG8_BAR; PG8_MMA(1, 0, At, B0); PG8_MMA(1, 1, At, B1); PG8_BAR; PG8_SCHED;
            PG8_LDB(B0, 1, 0); PG8_LDB(B1, 1, 1); PG8_SCHED; PG8_LDA(At, 1, 0); PG8_STAGE(PG8_SA(0, 1), a2 + hstep, voffA);
            PG8_WAIT_V(8); PG8_WAIT_L(0); PG8_BAR; PG8_MMA(0, 0, At, B0); PG8_MMA(0, 1, At, B1); PG8_BAR; PG8_SCHED;
            PG8_LDA(At, 1, 1); PG8_STAGE(PG8_SB(1, 0), b3, voffB); PG8_STAGE(PG8_SB(1, 1), b3 + hstep, voffB); PG8_STAGE(PG8_SA(1, 0), a3, voffA);
            PG8_WAIT_V(8); PG8_WAIT_L(0); PG8_BAR; PG8_MMA(1, 0, At, B0); PG8_MMA(1, 1, At, B1); PG8_BAR; PG8_SCHED;
            } else {
            PG8_LDB(B0, 0, 0); PG8_SCHED; PG8_LDA(At, 0, 0); PG8_STAGE(PG8_SA(1, 1), a1 + hstep, voffA);
            PG8_WAIT_L(8); PG8_BAR; PG8_WAIT_L(0); PG8_MMA(0, 0, At, B0); PG8_BAR; PG8_SCHED;
            PG8_LDB(B1, 0, 1); PG8_STAGE(PG8_SB(0, 0), b2, voffB);
            PG8_BAR; PG8_WAIT_L(0); PG8_MMA(0, 1, At, B1); PG8_BAR;
            PG8_LDA(At, 0, 1); PG8_STAGE(PG8_SA(0, 0), a2, voffA);
            PG8_BAR; PG8_WAIT_L(0); PG8_MMA(1, 0, At, B0); PG8_BAR; PG8_SCHED;
            PG8_STAGE(PG8_SB(0, 1), b2 + hstep, voffB);
            PG8_WAIT_V(6); PG8_BAR; PG8_MMA(1, 1, At, B1); PG8_BAR;
            PG8_LDB(B0, 1, 0); PG8_SCHED; PG8_LDA(At, 1, 0); PG8_STAGE(PG8_SA(0, 1), a2 + hstep, voffA);
            PG8_WAIT_L(8); PG8_BAR; PG8_WAIT_L(0); PG8_MMA(0, 0, At, B0); PG8_BAR; PG8_SCHED;
            PG8_LDB(B1, 1, 1); PG8_STAGE(PG8_SB(1, 0), b3, voffB);
            PG8_BAR; PG8_WAIT_L(0); PG8_MMA(0, 1, At, B1); PG8_BAR;
            PG8_LDA(At, 1, 1); PG8_STAGE(PG8_SA(1, 0), a3, voffA);
            PG8_BAR; PG8_WAIT_L(0); PG8_MMA(1, 0, At, B0); PG8_BAR; PG8_SCHED;
            PG8_STAGE(PG8_SB(1, 1), b3 + hstep, voffB);
            PG8_WAIT_V(6); PG8_BAR; PG8_MMA(1, 1, At, B1); PG8_BAR;
            }
        }
        if constexpr (ALIGN_EPI) { if (wr == 0) PG8_BAR; }
        if constexpr (!Epi::AFTER_DRAIN) { if constexpr (Epi::GROUPS) { if (cur.g < 7) E.regroup(acc, cur, cur.g + 1, wr); else E(acc, cur, wr, wc, fr, fq); } else E(acc, cur, wr, wc, fr, fq); S.done(cur); }
        if (!has_next) break;
        if (!Epi::GROUPS || nxt.g == 0) {
#pragma unroll
        for (int a = 0; a < 2; ++a)
#pragma unroll
            for (int b = 0; b < 2; ++b)
#pragma unroll
                for (int m = 0; m < 4; ++m)
#pragma unroll
                    for (int n = 0; n < 2; ++n) acc[a][b][m][n] = (f32x4){0.f, 0.f, 0.f, 0.f};
        }
        cur = nxt; cA = nA; cB = nB; ++ui;
        if constexpr (ALIGN_EPI) { if (wr == 1) PG8_BAR; }
    }
    PG8_WAIT_V(0);
    if constexpr (!ALIGN_EPI) { if (wr == 0) PG8_BAR; }
    PG8_BAR;
#undef PG8_SA
#undef PG8_SB
#undef PG8_STAGE
#undef PG8_LDA
#undef PG8_LDB
#undef PG8_MMA
#undef PG8_WAIT_V
#undef PG8_WAIT_L
#undef PG8_BAR
#undef PG8_SCHED
}
}

constexpr int NWAVES = 8, NTHREADS = 512;
constexpr int D = 4096, BATCH = 4, SEQ = 4096, T = BATCH * SEQ, DEPTH = 4;
constexpr int DI = 8192, HD = 64, NH = 128, NG = 8, NST = 128, CONVD = DI + 2 * NG * NST  , PROJ = DI + CONVD + NH  , PROJP = 18688  , PROJM = 18432  ;
constexpr int PH = 8, NK = 128, PK = 16, HALFD = 128, QD = PH * 2 * HALFD  , NEXP = NK * NK;
constexpr float LN_EPS = 1e-5f, RMS_EPS = 1e-5f;
constexpr float ALPHA = 1.681792830507429f;

constexpr size_t MiB = 1u << 20;
constexpr size_t WS_CTL = 0, CTL_ZERO_BYTES = 1 * MiB;
constexpr size_t SZ_W_SSD_IN = (size_t)PROJP * D * 2, SZ_W_SSD_OUT = (size_t)D * DI * 2, SZ_W_SC_IN = (size_t)3 * D * D * 2, SZ_W_SC_OUT = (size_t)D * D * 2, SZ_W_WQ = (size_t)QD * D * 2, SZ_W_UV = (size_t)NEXP * D * 2;
constexpr size_t WS_W_SSD_IN = 1 * MiB;
constexpr size_t WS_W_SSD_OUT = WS_W_SSD_IN + 2 * SZ_W_SSD_IN;
constexpr size_t WS_W_SC_IN = WS_W_SSD_OUT + 2 * SZ_W_SSD_OUT;
constexpr size_t WS_W_SC_OUT = WS_W_SC_IN + 2 * SZ_W_SC_IN;
constexpr size_t WS_W_WQ = WS_W_SC_OUT + 2 * SZ_W_SC_OUT;
constexpr size_t WS_W_U = WS_W_WQ + 4 * SZ_W_WQ;
constexpr size_t WS_W_V = WS_W_U + 4 * SZ_W_UV;
constexpr size_t WS_X32 = WS_W_V + 4 * SZ_W_UV;
constexpr size_t WS_XB = WS_X32 + (size_t)T * D * 4;
constexpr size_t WS_ZX = WS_XB + (size_t)T * D * 2;
constexpr size_t WS_XBC = WS_ZX + (size_t)T * PROJP * 2;
constexpr size_t WS_YB = WS_XBC + (size_t)T * CONVD * 2;
constexpr size_t WS_Q32 = WS_YB + (size_t)T * DI * 2;
constexpr size_t WS_DT = WS_Q32 + (size_t)T * QD * 4;
constexpr size_t WS_DA = WS_DT + (size_t)T * NH * 4;
constexpr size_t WS_EIDX = WS_DA + (size_t)T * NH * 4;
constexpr size_t WS_GATES = WS_EIDX + (size_t)T * 128 * 4;
constexpr size_t WS_RS = WS_GATES + (size_t)T * 128 * 4;
constexpr size_t WS_YBF = WS_RS + (size_t)2 * 4 * NEXP * 4;
constexpr size_t WS_DTACC = WS_YBF + (size_t)T * D * 2;
constexpr size_t WS_SS = WS_DTACC + (size_t)2 * T * NH * 4;
constexpr size_t WS_RAT = WS_SS + (size_t)2 * T * NG * 8;
constexpr size_t WS_END = WS_RAT + (size_t)T * NG * 4;
static_assert(WS_END <= (size_t)4096 * MiB, "workspace map exceeds 4 GiB");
constexpr int CW_BAR = 4096;
constexpr int CW_C = 16384;
constexpr int CW_ST = 65536;
static_assert((size_t)(CW_ST + 4 * 2 * 16384) * 4 <= 1u << 20, "CTL words inside the memset region");

constexpr int RING_BYTES = 131072;
constexpr int LDSCTL_OFF = RING_BYTES, MISC_OFF = LDSCTL_OFF + 320;
constexpr int LDS_BYTES = 147456;

#define GAS __attribute__((address_space(1)))
#define LAS __attribute__((address_space(3)))
typedef unsigned short bf16;
typedef unsigned v4u __attribute__((ext_vector_type(4)));
typedef float f32x4 __attribute__((ext_vector_type(4)));
typedef float f32x2 __attribute__((ext_vector_type(2)));
typedef __bf16 bf16x2_t __attribute__((ext_vector_type(2)));

__device__ __forceinline__ float bf_lo(unsigned w) { return __uint_as_float(w << 16); }
__device__ __forceinline__ float bf_hi(unsigned w) { return __uint_as_float(w & 0xffff0000u); }
__device__ __forceinline__ unsigned pk2(float lo, float hi) { return pg8::cvt_pk_bf16(lo, hi); }
#define DPP_ADD_STEP(v, ctrl, rmask) do { const int t_ = __builtin_amdgcn_update_dpp(0, __builtin_bit_cast(int, v), (ctrl), (rmask), 0xf, false); v += __builtin_bit_cast(float, t_); } while (0)
__device__ __forceinline__ float wave_sum(float v) {
    DPP_ADD_STEP(v, 0xB1, 0xf); DPP_ADD_STEP(v, 0x4E, 0xf); DPP_ADD_STEP(v, 0x141, 0xf); DPP_ADD_STEP(v, 0x140, 0xf);
    DPP_ADD_STEP(v, 0x142, 0xa); DPP_ADD_STEP(v, 0x143, 0xc);
    return __builtin_bit_cast(float, __builtin_amdgcn_readlane(__builtin_bit_cast(int, v), 63));
}
__device__ __forceinline__ float wave_max(float v) {
#pragma unroll
    for (int o = 1; o < 64; o <<= 1) v = fmaxf(v, __shfl_xor(v, o));
    return v;
}
__device__ __forceinline__ float dot2bf(unsigned a, unsigned b, float acc) { return __builtin_amdgcn_fdot2_f32_bf16(__builtin_bit_cast(bf16x2_t, a), __builtin_bit_cast(bf16x2_t, b), acc, false); }
__device__ __forceinline__ float dot8(const v4u a, const v4u b, float s) { s = dot2bf(a.x, b.x, s); s = dot2bf(a.y, b.y, s); s = dot2bf(a.z, b.z, s); s = dot2bf(a.w, b.w, s); return s; }
#define DPP_MAX_STEP(v, ctrl, rmask) do { const int t_ = __builtin_amdgcn_update_dpp(__builtin_bit_cast(int, v), __builtin_bit_cast(int, v), (ctrl), (rmask), 0xf, false); v = fmaxf(v, __builtin_bit_cast(float, t_)); } while (0)
__device__ __forceinline__ float wave_max_u(float v) {
    DPP_MAX_STEP(v, 0xB1, 0xf);
    DPP_MAX_STEP(v, 0x4E, 0xf);
    DPP_MAX_STEP(v, 0x141, 0xf);
    DPP_MAX_STEP(v, 0x140, 0xf);
    DPP_MAX_STEP(v, 0x142, 0xa);
    DPP_MAX_STEP(v, 0x143, 0xc);
    return __builtin_bit_cast(float, __builtin_amdgcn_readlane(__builtin_bit_cast(int, v), 63));
}
__device__ __forceinline__ float silu_f(float x) { return x * __builtin_amdgcn_rcpf(1.f + __expf(-x)); }

#define XB_TMO      128
#define XB_XCNT(j)  (256  + 64 * (j))
#define XB_XSUB(j)  (1280 + 64 * (j))
#define XB_XGEN(j)  (2304 + 64 * (j))
#define XB_TOP      3328
#define XB_TOPGEN   3392
#define XCD_BAR_WORDS 3456
#define XB_SPIN_CAP (1u << 18)
__device__ __forceinline__ unsigned xb_ld(unsigned* p)              { return __hip_atomic_load(p, __ATOMIC_RELAXED, __HIP_MEMORY_SCOPE_AGENT); }
__device__ __forceinline__ unsigned xb_add(unsigned* p, unsigned v) { return __hip_atomic_fetch_add(p, v, __ATOMIC_RELAXED, __HIP_MEMORY_SCOPE_AGENT); }
__device__ __forceinline__ unsigned xb_xcc_id() { return (unsigned)__builtin_amdgcn_s_getreg((3 << 11) | 20) & 0xFu; }
#define XB_SPIN(cond, bar) do { unsigned _sp = 0; while (cond) { __builtin_amdgcn_s_sleep(1); \
    if ((++_sp & 255u) == 0u) { if (xb_ld(&(bar)[XB_TMO])) break; if (_sp > XB_SPIN_CAP) { atomicAdd(&(bar)[XB_TMO], 1u); break; } } } } while (0)
struct XcdBarrier { unsigned* bar; unsigned x; volatile LAS unsigned* st; };
__device__ __forceinline__ XcdBarrier xcd_barrier_post(unsigned* bar, volatile LAS unsigned* st) {
    XcdBarrier b; b.bar = bar; b.x = xb_xcc_id(); b.st = st;
    if (threadIdx.x == 0) (void)xb_add(&bar[XB_XCNT(b.x)], 1u);
    return b;
}
__device__ __forceinline__ void xcd_barrier_complete(unsigned* bar, unsigned x, unsigned& nloc, unsigned& nx) {
    const unsigned G = gridDim.x * gridDim.y * gridDim.z;
    unsigned sum, cnt, mine, sp = 0u;
    for (;;) {
        sum = 0u; cnt = 0u; mine = 0u;
#pragma unroll
        for (unsigned j = 0; j < 16; ++j) { const unsigned c = xb_ld(&bar[XB_XCNT(j)]); sum += c; cnt += (c > 0u) ? 1u : 0u; mine = (j == x) ? c : mine; }
        if (sum == G) break;
        __builtin_amdgcn_s_sleep(1);
        if ((++sp & 255u) == 0u) { if (xb_ld(&bar[XB_TMO])) break; if (sp > XB_SPIN_CAP) { atomicAdd(&bar[XB_TMO], 1u); break; } }
    }
    nloc = mine > 0u ? mine : 1u; nx = cnt > 0u ? cnt : 1u;
}
__device__ __forceinline__ void xcd_barrier(const XcdBarrier& b) {
    asm volatile("s_waitcnt vmcnt(0)" ::: "memory");
    __syncthreads();
    if (threadIdx.x == 0) {
        unsigned* bar = b.bar;
        __builtin_amdgcn_s_waitcnt(0);
        unsigned nloc = b.st[0], nx = b.st[1];
        if (nloc == 0u) { xcd_barrier_complete(bar, b.x, nloc, nx); b.st[0] = nloc; b.st[1] = nx; }
        const unsigned old = xb_add(&bar[XB_XSUB(b.x)], 1u);
        const unsigned gen = old / nloc;
        if (old + 1u == (gen + 1u) * nloc) {
            __builtin_amdgcn_fence(__ATOMIC_RELEASE, "agent");
            asm volatile("s_waitcnt vmcnt(0)" ::: "memory");
            const unsigned og = xb_add(&bar[XB_TOP], 1u);
            const unsigned tg = og / nx;
            if (og + 1u == (tg + 1u) * nx) xb_add(&bar[XB_TOPGEN], 1u);
            else XB_SPIN(xb_ld(&bar[XB_TOPGEN]) == tg, bar);
            __builtin_amdgcn_fence(__ATOMIC_ACQUIRE, "agent");
            xb_add(&bar[XB_XGEN(b.x)], 1u);
            asm volatile("s_waitcnt vmcnt(0)" ::: "memory");
        } else {
            XB_SPIN(xb_ld(&bar[XB_XGEN(b.x)]) == gen, bar);
            __builtin_amdgcn_fence(__ATOMIC_ACQUIRE, "agent");
            asm volatile("s_waitcnt vmcnt(0)" ::: "memory");
        }
    }
    __syncthreads();
}

struct Args {
    const float* in[20]; float* out; unsigned char* ws; int ph_lo, ph_hi, use_bar, pad;
};
typedef const __attribute__((address_space(4))) Args* KArgs;
#define KA() ({ KArgs p_ = (KArgs)__builtin_amdgcn_kernarg_segment_ptr(); asm volatile("" : "+s"(p_)); p_; })
namespace pg8 {
__device__ __forceinline__ const float* epi_rat() { KArgs ka = KA(); return (const float*)(ka->ws + WS_RAT); }
__device__ __forceinline__ int* epi_dtacc(int j) { KArgs ka = KA(); return (int*)(ka->ws + WS_DTACC) + (size_t)j * T * NH; }
__device__ __forceinline__ EpiPtrs epi_ptrs(int layer) {
    KArgs ka = KA(); unsigned char* w = ka->ws; EpiPtrs P;
    P.resb = (const bf16_t*)(w + WS_XB); P.out = ka->out; P.ybf = (bf16_t*)(w + WS_YBF);
    P.s1 = (float*)(w + WS_CTL) + CW_ST + layer * 2 * T; P.s2 = P.s1 + T; P.q32 = (float*)(w + WS_Q32);
    P.c1 = (const float*)(w + WS_CTL) + CW_C + layer * 4096; P.c2 = P.c1 + 2048; return P;
}
}
struct Frame {
    LAS unsigned char* lds;
    int tid, lane, wave, G, gw, NGW;
};

__device__ __forceinline__ void p0_transpose_item(const float* __restrict__ W, int K, int N, bf16* WT, LAS float* scr, int item, int lane, const float* rsc = nullptr) {
    const int nblk = N / 32, kb = item / nblk, nb = item % nblk, k0 = 64 * kb, n0 = 32 * nb;
    { f32x4 t4[8];
#pragma unroll
      for (int i = 0; i < 8; ++i) t4[i] = __builtin_nontemporal_load((const f32x4*)(W + (size_t)(k0 + 8 * i + (lane >> 3)) * N + n0 + 4 * (lane & 7)));
#pragma unroll
      for (int i = 0; i < 8; ++i) { LAS float* d = scr + (8 * i + (lane >> 3)) * 33 + 4 * (lane & 7); d[0] = t4[i][0]; d[1] = t4[i][1]; d[2] = t4[i][2]; d[3] = t4[i][3]; } }
    asm volatile("s_waitcnt lgkmcnt(0)" ::: "memory");
    const int c = lane & 7;
    f32x4 ga = (f32x4){1.f, 1.f, 1.f, 1.f}, gb = ga; if (rsc) { ga = *(const f32x4*)(rsc + k0 + 8 * c); gb = *(const f32x4*)(rsc + k0 + 8 * c + 4); }
#pragma unroll
    for (int j = 0; j < 4; ++j) { const int n = (lane >> 3) + 8 * j; const LAS float* s = scr + (8 * c) * 33 + n;
        v4u o; o.x = pk2(ga[0] * s[0 * 33], ga[1] * s[1 * 33]); o.y = pk2(ga[2] * s[2 * 33], ga[3] * s[3 * 33]); o.z = pk2(gb[0] * s[4 * 33], gb[1] * s[5 * 33]); o.w = pk2(gb[2] * s[6 * 33], gb[3] * s[7 * 33]);
        __builtin_nontemporal_store(o, (v4u*)(WT + (size_t)(n0 + n) * K + k0 + 8 * c)); }
    asm volatile("s_waitcnt lgkmcnt(0)" ::: "memory");
}
__device__ __forceinline__ void p0_transpose_item_wq(const float* __restrict__ W, int K, int N, bf16* WT, LAS float* scr, int item, int lane, const float* g1, const float* b1, float* c1, float* c2) {
    const int nblk = N / 32, kb = item / nblk, nb = item % nblk, k0 = 64 * kb, n0 = 32 * nb;
    { f32x4 t4[8];
#pragma unroll
      for (int i = 0; i < 8; ++i) t4[i] = __builtin_nontemporal_load((const f32x4*)(W + (size_t)(k0 + 8 * i + (lane >> 3)) * N + n0 + 4 * (lane & 7)));
#pragma unroll
      for (int i = 0; i < 8; ++i) { LAS float* d = scr + (8 * i + (lane >> 3)) * 33 + 4 * (lane & 7); d[0] = t4[i][0]; d[1] = t4[i][1]; d[2] = t4[i][2]; d[3] = t4[i][3]; } }
    asm volatile("s_waitcnt lgkmcnt(0)" ::: "memory");
    { const int n = lane & 31, hf = lane >> 5; float a1 = 0.f, a2 = 0.f;
      for (int kk = 0; kk < 32; ++kk) { const int k = 32 * hf + kk; const float w = scr[k * 33 + n]; a1 += __uint_as_float(pk2(g1[k0 + k] * w, 0.f) << 16); a2 += b1[k0 + k] * w; }
      a1 += __shfl_xor(a1, 32); a2 += __shfl_xor(a2, 32);
      if (lane < 32) { atomicAdd((int*)c1 + n0 + n, __float2int_rn(a1 * 16777216.f)); atomicAdd((int*)c2 + n0 + n, __float2int_rn(a2 * 16777216.f)); } }
    const int c = lane & 7;
    const f32x4 ga = *(const f32x4*)(g1 + k0 + 8 * c), gb = *(const f32x4*)(g1 + k0 + 8 * c + 4);
#pragma unroll
    for (int j = 0; j < 4; ++j) { const int n = (lane >> 3) + 8 * j; const LAS float* s = scr + (8 * c) * 33 + n;
        v4u o; o.x = pk2(ga[0] * s[0 * 33], ga[1] * s[1 * 33]); o.y = pk2(ga[2] * s[2 * 33], ga[3] * s[3 * 33]); o.z = pk2(gb[0] * s[4 * 33], gb[1] * s[5 * 33]); o.w = pk2(gb[2] * s[6 * 33], gb[3] * s[7 * 33]);
        __builtin_nontemporal_store(o, (v4u*)(WT + (size_t)(n0 + n) * K + k0 + 8 * c)); }
    asm volatile("s_waitcnt lgkmcnt(0)" ::: "memory");
}
__device__ __forceinline__ void cvt_rows(const float* __restrict__ src, bf16* dst, size_t n8, size_t gtid, size_t nthr) {
    for (size_t i = gtid; i < n8; i += nthr) { const f32x4 a = ((const f32x4*)src)[2 * i], b = ((const f32x4*)src)[2 * i + 1];
        v4u o; o.x = pk2(a[0], a[1]); o.y = pk2(a[2], a[3]); o.z = pk2(b[0], b[1]); o.w = pk2(b[2], b[3]); ((v4u*)dst)[i] = o; }
}
__device__ __forceinline__ void p0_prologue(const Frame& F, KArgs a) {
    unsigned char* ws = a->ws;
    LAS float* scr = (LAS float*)(F.lds + F.wave * 16384);
    constexpr int I_SSD_IN = (D / 64) * (PROJ / 32), I_SSD_OUT = (DI / 64) * (D / 32), I_SC_IN = (D / 64) * (3 * D / 32), I_SC_OUT = (D / 64) * (D / 32), I_WQ = (D / 64) * (QD / 32);
    constexpr int NITEMS = 2 * (I_SSD_IN + I_SSD_OUT + I_SC_IN + I_SC_OUT) + 4 * I_WQ;
    for (int it = F.gw; it < NITEMS; it += F.NGW) {
        int r = it;
        if (r < 2 * I_SSD_IN) { const int j = r / I_SSD_IN; r -= j * I_SSD_IN; p0_transpose_item(a->in[1] + (size_t)j * D * PROJ, D, PROJ, (bf16*)(ws + WS_W_SSD_IN + j * SZ_W_SSD_IN), scr, r, F.lane); continue; } r -= 2 * I_SSD_IN;
        if (r < 2 * I_SSD_OUT) { const int j = r / I_SSD_OUT; r -= j * I_SSD_OUT; p0_transpose_item(a->in[8] + (size_t)j * DI * D, DI, D, (bf16*)(ws + WS_W_SSD_OUT + j * SZ_W_SSD_OUT), scr, r, F.lane, a->in[7] + (size_t)j * DI  ); continue; } r -= 2 * I_SSD_OUT;
        if (r < 2 * I_SC_IN) { const int j = r / I_SC_IN; r -= j * I_SC_IN; p0_transpose_item(a->in[9] + (size_t)j * D * 3 * D, D, 3 * D, (bf16*)(ws + WS_W_SC_IN + j * SZ_W_SC_IN), scr, r, F.lane); continue; } r -= 2 * I_SC_IN;
        if (r < 2 * I_SC_OUT) { const int j = r / I_SC_OUT; r -= j * I_SC_OUT; p0_transpose_item(a->in[11] + (size_t)j * D * D, D, D, (bf16*)(ws + WS_W_SC_OUT + j * SZ_W_SC_OUT), scr, r, F.lane); continue; } r -= 2 * I_SC_OUT;
        { const int j = r / I_WQ; r -= j * I_WQ; float* cc = (float*)(ws + WS_CTL) + CW_C + j * 4096;
          p0_transpose_item_wq(a->in[12] + (size_t)j * D * QD, D, QD, (bf16*)(ws + WS_W_WQ + j * SZ_W_WQ), scr, r, F.lane, a->in[16] + (size_t)j * D, a->in[17] + (size_t)j * D, cc, cc + 2048); }
    }
    const size_t gtid = (size_t)blockIdx.x * NTHREADS + F.tid, nthr = (size_t)F.G * NTHREADS;
    for (int j = 0; j < 2; ++j) { v4u* p = (v4u*)(ws + WS_W_SSD_IN + j * SZ_W_SSD_IN + (size_t)PROJ * D * 2); const size_t n16 = (size_t)(PROJP - PROJ) * D * 2 / 16;
        for (size_t i = gtid; i < n16; i += nthr) p[i] = (v4u){0u, 0u, 0u, 0u}; }
    for (int r = F.gw; r < 2 * 4 * NEXP; r += F.NGW) {
        const int tbl = r / (4 * NEXP), rr = r % (4 * NEXP);
        const float* srow = a->in[14 + tbl] + (size_t)rr * D;
        f32x4 v[16]; float am = 0.f;
#pragma unroll
        for (int i = 0; i < 2; ++i)
#pragma unroll
            for (int k = 0; k < 8; ++k) { v[i * 8 + k] = __builtin_nontemporal_load((const f32x4*)(srow + i * 2048 + k * 256 + F.lane * 4));
                am = fmaxf(am, fmaxf(fmaxf(fabsf(v[i * 8 + k][0]), fabsf(v[i * 8 + k][1])), fmaxf(fabsf(v[i * 8 + k][2]), fabsf(v[i * 8 + k][3])))); }
        am = fmaxf(wave_max(am), 1e-30f);
        const float sc = 6.0f / am;
        unsigned char* drow = ws + WS_W_U + (size_t)rr * D + (size_t)tbl * (D / 2);
#pragma unroll
        for (int i = 0; i < 2; ++i) { v4u o;
#pragma unroll
            for (int k = 0; k < 4; ++k) { const f32x4 q0 = v[i * 8 + 2 * k] * sc, q1 = v[i * 8 + 2 * k + 1] * sc; unsigned w = 0u;
                w = __builtin_amdgcn_cvt_scalef32_pk_fp4_f32(w, q0[0], q0[1], 1.0f, 0); w = __builtin_amdgcn_cvt_scalef32_pk_fp4_f32(w, q0[2], q0[3], 1.0f, 1);
                w = __builtin_amdgcn_cvt_scalef32_pk_fp4_f32(w, q1[0], q1[1], 1.0f, 2); w = __builtin_amdgcn_cvt_scalef32_pk_fp4_f32(w, q1[2], q1[3], 1.0f, 3); o[k] = w; }
            __builtin_nontemporal_store(o, (v4u*)(drow + (size_t)(i * 64 + F.lane) * 16)); }
        if (F.lane == 0) ((float*)(ws + WS_RS))[r] = am * (1.0f / 6.0f);
    }
    cvt_rows(a->in[0], (bf16*)(ws + WS_XB), (size_t)T * D / 8, gtid, nthr);
}

__device__ __forceinline__ void ssd_conv_phase(const Frame& F, KArgs a, int j) {
    const bf16* ZX = (const bf16*)(a->ws + WS_ZX); bf16* XBC = (bf16*)(a->ws + WS_XBC);
    const float* cw = a->in[2] + (size_t)j * 4 * CONVD; const float* cb = a->in[3] + (size_t)j * CONVD;
    constexpr int NCB = CONVD / 512, NITEMS = (T / 32) * NCB;
    for (int it = F.gw; it < NITEMS; it += F.NGW) {
        const int tb = it / NCB, cbk = it % NCB, c0 = cbk * 512 + F.lane * 8, t0 = tb * 32;
        float w[4][8], bias[8];
#pragma unroll
        for (int k = 0; k < 4; ++k) { const f32x4 u0 = *(const f32x4*)(cw + (size_t)k * CONVD + c0), u1 = *(const f32x4*)(cw + (size_t)k * CONVD + c0 + 4);
#pragma unroll
            for (int e = 0; e < 4; ++e) { w[k][e] = u0[e]; w[k][4 + e] = u1[e]; } }
        { const f32x4 u0 = *(const f32x4*)(cb + c0), u1 = *(const f32x4*)(cb + c0 + 4);
#pragma unroll
          for (int e = 0; e < 4; ++e) { bias[e] = u0[e]; bias[4 + e] = u1[e]; } }
        float r0[8], r1[8], r2[8];
        const bool head = (t0 % SEQ) == 0;
#pragma unroll
        for (int h = 0; h < 3; ++h) {
            v4u v = (v4u){0u, 0u, 0u, 0u};
            if (!head) v = *(const v4u*)(ZX + (size_t)(t0 - 3 + h) * PROJP + DI + c0);
            float* dst = h == 0 ? r0 : (h == 1 ? r1 : r2);
#pragma unroll
            for (int e = 0; e < 4; ++e) { dst[2 * e] = bf_lo(v[e]); dst[2 * e + 1] = bf_hi(v[e]); }
        }
        for (int tt0 = 0; tt0 < 32; tt0 += 8) {
            v4u vv[8];
#pragma unroll
            for (int k = 0; k < 8; ++k) vv[k] = __builtin_nontemporal_load((const v4u*)(ZX + (size_t)(t0 + tt0 + k) * PROJP + DI + c0));
#pragma unroll
            for (int k = 0; k < 8; ++k) {
                const v4u v = vv[k];
                float cur[8], o[8];
#pragma unroll
                for (int e = 0; e < 4; ++e) { cur[2 * e] = bf_lo(v[e]); cur[2 * e + 1] = bf_hi(v[e]); }
#pragma unroll
                for (int e = 0; e < 8; ++e) { const float s = bias[e] + w[0][e] * r0[e] + w[1][e] * r1[e] + w[2][e] * r2[e] + w[3][e] * cur[e]; o[e] = silu_f(s); r0[e] = r1[e]; r1[e] = r2[e]; r2[e] = cur[e]; }
                v4u ov; ov.x = pk2(o[0], o[1]); ov.y = pk2(o[2], o[3]); ov.z = pk2(o[4], o[5]); ov.w = pk2(o[6], o[7]);
                __builtin_nontemporal_store(ov, (v4u*)(XBC + (size_t)(t0 + tt0 + k) * CONVD + c0));
            }
        }
    }
    float* DT = (float*)(a->ws + WS_DT); const int* DTACC = (const int*)(a->ws + WS_DTACC) + (size_t)j * T * NH;
    const float* dtb = a->in[4] + j * NH;
    const size_t gtid = (size_t)blockIdx.x * NTHREADS + F.tid, nthr = (size_t)F.G * NTHREADS;
    for (size_t i = gtid; i < (size_t)T * NH; i += nthr) {
        const int h = (int)(i % NH); const size_t t = i / NH;
        const float raw = (float)DTACC[i] * (1.0f / 1048576.f) + dtb[h];
        const float dt = raw > 20.f ? raw : log1pf(expf(raw));
        DT[i] = dt;
    }
}

__device__ __forceinline__ void ssd_scan_phase(const Frame& F, KArgs a, int j) {
    const bf16* XBC = (const bf16*)(a->ws + WS_XBC); bf16* YB = (bf16*)(a->ws + WS_YB);
    const float* DT = (const float*)(a->ws + WS_DT); const float* DA = (const float*)(a->ws + WS_DA);
    const float* Dsk = a->in[6] + j * NH;
    LAS float* Bs = (LAS float*)(F.lds);
    LAS float* Cs = (LAS float*)(F.lds + 16384);
    LAS float* Xs = (LAS float*)(F.lds + 32768);
    LAS float* DTs = (LAS float*)(F.lds + 49152);
    LAS float* DAs = (LAS float*)(F.lds + 49152 + 256);
    LAS float* YP = (LAS float*)(F.lds + 65536);
    const int hl = F.wave >> 2, nq = F.wave & 3;
    for (int unit = blockIdx.x; unit < BATCH * (NH / 2); unit += F.G) {
        const int b = unit / (NH / 2), hp = unit % (NH / 2), g = hp >> 3, hg0 = 2 * hp;
        float hst[32];
#pragma unroll
        for (int n = 0; n < 32; ++n) hst[n] = 0.f;
        const int ltt = F.tid >> 4, lcol = (F.tid & 15) * 8;
        v4u vb, vc, vx; float pdt = 0.f, pda = 0.f;
#define SCAN_LOAD(blk_) do { const size_t tg_ = (size_t)b * SEQ + (size_t)(blk_) * 32; const bf16* rowp = XBC + (tg_ + ltt) * CONVD; \
            vb = *(const v4u*)(rowp + DI + g * NST + lcol); vc = *(const v4u*)(rowp + DI + NG * NST + g * NST + lcol); vx = *(const v4u*)(rowp + hg0 * HD + lcol); \
            if (F.tid < 64) { const int t2 = F.tid >> 1, hh = F.tid & 1; pdt = DT[(tg_ + t2) * NH + hg0 + hh]; pda = DA[(tg_ + t2) * NH + hg0 + hh]; } } while (0)
        SCAN_LOAD(0);
        for (int blk = 0; blk < SEQ / 32; ++blk) {
            const size_t tg0 = (size_t)b * SEQ + (size_t)blk * 32;
            {
                const int tt = ltt, col = lcol;
#pragma unroll
                for (int e = 0; e < 4; ++e) { Bs[tt * 128 + col + 2 * e] = bf_lo(vb[e]); Bs[tt * 128 + col + 2 * e + 1] = bf_hi(vb[e]);
                    Cs[tt * 128 + col + 2 * e] = bf_lo(vc[e]); Cs[tt * 128 + col + 2 * e + 1] = bf_hi(vc[e]);
                    Xs[tt * 128 + col + 2 * e] = bf_lo(vx[e]); Xs[tt * 128 + col + 2 * e + 1] = bf_hi(vx[e]); }
                if (F.tid < 64) { DTs[F.tid] = pdt; DAs[F.tid] = pda; }
            }
            __syncthreads();
            if (blk + 1 < SEQ / 32) SCAN_LOAD(blk + 1);
            for (int tt = 0; tt < 32; ++tt) {
                const float dtv = DTs[tt * 2 + hl], dav = DAs[tt * 2 + hl], xv = Xs[tt * 128 + hl * 64 + F.lane];
                const float dx = dtv * xv; float y = 0.f;
#pragma unroll
                for (int n4 = 0; n4 < 8; ++n4) {
                    const f32x4 bv = *(const LAS f32x4*)(Bs + tt * 128 + nq * 32 + n4 * 4), cv = *(const LAS f32x4*)(Cs + tt * 128 + nq * 32 + n4 * 4);
#pragma unroll
                    for (int e = 0; e < 4; ++e) { hst[n4 * 4 + e] = dav * hst[n4 * 4 + e] + dx * bv[e]; y += cv[e] * hst[n4 * 4 + e]; }
                }
                YP[(tt * 8 + F.wave) * 64 + F.lane] = y;
            }
            __syncthreads();
#pragma unroll
            for (int k = 0; k < 8; ++k) {
                const int idx = F.tid + 512 * k, tt = idx >> 7, ch = idx & 127, h2 = ch >> 6, p = ch & 63;
                float y = Dsk[hg0 + h2] * Xs[tt * 128 + ch];
#pragma unroll
                for (int q = 0; q < 4; ++q) y += YP[(tt * 8 + h2 * 4 + q) * 64 + p];
                YB[(tg0 + tt) * DI + hg0 * HD + ch] = (bf16)(pk2(y, 0.f) & 0xffffu);
            }
            __syncthreads();
        }
#undef SCAN_LOAD
    }
}

__device__ __forceinline__ unsigned pk2c(float lo, float hi) { const bf16x2_t v = {(__bf16)lo, (__bf16)hi}; return __builtin_bit_cast(unsigned, v); }
typedef short bf16x8 __attribute__((ext_vector_type(8)));
typedef unsigned v2u __attribute__((ext_vector_type(2)));
constexpr int SC_RS = 272;
constexpr int SC_TILE = 64 * SC_RS;
constexpr int SC_STAGE = 3 * SC_TILE;
constexpr int SC_YS = 2 * SC_STAGE;
constexpr int SC_PRIV = SC_YS + SC_TILE;
constexpr int SC_CB = RING_BYTES + 2048;
static_assert(SC_PRIV + 8 * 1024 <= RING_BYTES && SC_CB + 10 * 1024 <= LDS_BYTES, "scan LDS map");
__device__ __forceinline__ v2u lds_tr2(unsigned addr) { v2u r; asm volatile("ds_read_b64_tr_b16 %0, %1\n\ts_waitcnt lgkmcnt(0)" : "=&v"(r) : "v"(addr) : "memory"); return r; }
__device__ __forceinline__ bf16x8 mk8(v2u a, v2u b) { const v4u t = (v4u){a.x, a.y, b.x, b.y}; return __builtin_bit_cast(bf16x8, t); }
__device__ __forceinline__ bf16x8 lds_tr8(unsigned a0, unsigned a1) { v2u r0, r1; asm volatile("ds_read_b64_tr_b16 %0, %2\n\tds_read_b64_tr_b16 %1, %3\n\ts_waitcnt lgkmcnt(0)" : "=&v"(r0), "=&v"(r1) : "v"(a0), "v"(a1) : "memory"); return mk8(r0, r1); }
__device__ __forceinline__ void lds_tr8x4(unsigned base, bf16x8 (&o)[4]) {
    v2u r0, r1, r2, r3, r4, r5, r6, r7;
    asm volatile("ds_read_b64_tr_b16 %0, %8\n\tds_read_b64_tr_b16 %1, %8 offset:1088\n\tds_read_b64_tr_b16 %2, %8 offset:32\n\tds_read_b64_tr_b16 %3, %8 offset:1120\n\t"
                 "ds_read_b64_tr_b16 %4, %8 offset:64\n\tds_read_b64_tr_b16 %5, %8 offset:1152\n\tds_read_b64_tr_b16 %6, %8 offset:96\n\tds_read_b64_tr_b16 %7, %8 offset:1184\n\ts_waitcnt lgkmcnt(0)"
                 : "=&v"(r0), "=&v"(r1), "=&v"(r2), "=&v"(r3), "=&v"(r4), "=&v"(r5), "=&v"(r6), "=&v"(r7) : "v"(base) : "memory");
    o[0] = mk8(r0, r1); o[1] = mk8(r2, r3); o[2] = mk8(r4, r5); o[3] = mk8(r6, r7);
}
static_assert(4 * SC_RS == 1088, "lds_tr8x4 immediates assume a 272-byte row stride");
__device__ __forceinline__ bf16x8 pack8(const f32x4 a, const f32x4 b) { const v4u t = (v4u){pk2c(a[0], a[1]), pk2c(a[2], a[3]), pk2c(b[0], b[1]), pk2c(b[2], b[3])}; return __builtin_bit_cast(bf16x8, t); }
#define DPP_SCAN_STEP(v, ctrl, rmask) do { const int t_ = __builtin_amdgcn_update_dpp(0, __builtin_bit_cast(int, v), (ctrl), (rmask), 0xf, false); v += __builtin_bit_cast(float, t_); } while (0)
__device__ __forceinline__ void ssd_scan_mfma_phase(const Frame& F, KArgs a, int j) {
    const bf16* XBC = (const bf16*)(a->ws + WS_XBC); bf16* YB = (bf16*)(a->ws + WS_YB);
    const float* DT = (const float*)(a->ws + WS_DT);
    const unsigned ldsb = (unsigned)(size_t)F.lds;
    const int hl = F.wave >> 2, pq = F.wave & 3, r = F.lane & 15, q = F.lane >> 4;
    const int ch0 = hl * 64 + pq * 16;
    LAS float* PRIV = (LAS float*)(F.lds + SC_PRIV + F.wave * 1024);
    LAS float* ACS = PRIV; LAS float* DTV = PRIV + 64; LAS float* EA = PRIV + 128; LAS float* WB = PRIV + 192;
    LAS float* ACSo = (LAS float*)(F.lds + SC_CB + 10240 + F.wave * 512); LAS float* DTVo = ACSo + 64;
    const int tq = (F.lane & 15) >> 2, tp = F.lane & 3;
    for (int unit = blockIdx.x; unit < BATCH * NG * 8; unit += F.G) {
        const int b = unit >> 6, g = (unit >> 3) & 7, e = unit & 7, hg0 = g * 16 + 2 * e, hg = hg0 + hl;
        const float aneg = -__expf(a->in[5][j * NH + hg]); const float dsk = a->in[6][j * NH + hg]; const float anego = -__expf(a->in[5][j * NH + (hg ^ 1)]);
        f32x4 S[8];
#pragma unroll
        for (int n = 0; n < 8; ++n) S[n] = (f32x4){0.f, 0.f, 0.f, 0.f};
        v4u pre[6]; float pdt, pdo;
        unsigned vo0 = (unsigned)(((F.tid >> 4) * CONVD + (F.tid & 15) * 8) * 2); asm volatile("" : "+v"(vo0));
        const unsigned vdt = (unsigned)(F.lane * NH * 4);
#define SCM_LOAD(c_) do { const size_t t0_ = (size_t)b * SEQ + (size_t)(c_) * 64; const char* pB = (const char*)(XBC + t0_ * CONVD + DI + g * NST); const char* pC = pB + NG * NST * 2; const char* pX = (const char*)(XBC + t0_ * CONVD + hg0 * HD); \
            _Pragma("unroll") for (int k = 0; k < 2; ++k) { pre[k] = *(const v4u*)(pB + (size_t)k * 32 * CONVD * 2 + vo0); pre[2 + k] = *(const v4u*)(pC + (size_t)k * 32 * CONVD * 2 + vo0); pre[4 + k] = __builtin_nontemporal_load((const v4u*)(pX + (size_t)k * 32 * CONVD * 2 + vo0)); } \
            pdt = *(const float*)((const char*)(DT + t0_ * NH + hg) + vdt); pdo = *(const float*)((const char*)(DT + t0_ * NH + (hg ^ 1)) + vdt); } while (0)
#define SCM_STORE(stage_) do { _Pragma("unroll") for (int k = 0; k < 2; ++k) { const int piece = F.tid + 512 * k, row = piece >> 4, c16 = piece & 15; LAS unsigned char* d = F.lds + (stage_) * SC_STAGE + row * SC_RS + c16 * 16; \
                *(LAS v4u*)(d) = pre[k]; *(LAS v4u*)(d + SC_TILE) = pre[2 + k]; *(LAS v4u*)(d + 2 * SC_TILE) = pre[4 + k]; } } while (0)
        __syncthreads();
        SCM_LOAD(0); SCM_STORE(0);
        float dtc = pdt, dto = pdo;
        __syncthreads();
        for (int c = 0; c < SEQ / 64; ++c) {
            const int st = c & 1; const size_t t0 = (size_t)b * SEQ + (size_t)c * 64;
            if (c + 1 < SEQ / 64) SCM_LOAD(c + 1);
            v4u zpre[2];
            { const char* pZ = (const char*)((const bf16*)(a->ws + WS_ZX) + t0 * PROJP + hg0 * HD); const unsigned vz = (unsigned)(((F.tid >> 4) * PROJP + (F.tid & 15) * 8) * 2);
#pragma unroll
              for (int k = 0; k < 2; ++k) zpre[k] = __builtin_nontemporal_load((const v4u*)(pZ + (size_t)k * 32 * PROJP * 2 + vz)); }
            const unsigned Bb = ldsb + st * SC_STAGE, Cb = Bb + SC_TILE, Xb = Bb + 2 * SC_TILE;
            LAS unsigned char* Bp = F.lds + st * SC_STAGE; LAS unsigned char* Cp = Bp + SC_TILE;
            { float acs = dtc * aneg;
              DPP_SCAN_STEP(acs, 0x111, 0xf); DPP_SCAN_STEP(acs, 0x112, 0xf); DPP_SCAN_STEP(acs, 0x114, 0xf); DPP_SCAN_STEP(acs, 0x118, 0xf);
              DPP_SCAN_STEP(acs, 0x142, 0xa); DPP_SCAN_STEP(acs, 0x143, 0xc);
              const float a63 = __builtin_bit_cast(float, __builtin_amdgcn_readlane(__builtin_bit_cast(int, acs), 63));
              ACS[F.lane] = acs; DTV[F.lane] = dtc; EA[F.lane] = __expf(acs); WB[F.lane] = __expf(a63 - acs) * dtc;
              float aco = dto * anego;
              DPP_SCAN_STEP(aco, 0x111, 0xf); DPP_SCAN_STEP(aco, 0x112, 0xf); DPP_SCAN_STEP(aco, 0x114, 0xf); DPP_SCAN_STEP(aco, 0x118, 0xf);
              DPP_SCAN_STEP(aco, 0x142, 0xa); DPP_SCAN_STEP(aco, 0x143, 0xc);
              ACSo[F.lane] = aco; DTVo[F.lane] = dto; }
            const float eT = __expf(__builtin_bit_cast(float, __builtin_amdgcn_readlane(__builtin_bit_cast(int, ACS[63]), 0)));
            asm volatile("s_waitcnt lgkmcnt(0)" ::: "memory");
            f32x4 yacc[4];
#pragma unroll
            for (int lt = 0; lt < 4; ++lt) yacc[lt] = (f32x4){0.f, 0.f, 0.f, 0.f};
#pragma unroll
            for (int kn = 0; kn < 4; ++kn) {
                const bf16x8 sb = pack8(S[2 * kn], S[2 * kn + 1]);
#pragma unroll
                for (int lt = 0; lt < 4; ++lt) {
                    const LAS unsigned char* cr = Cp + (16 * lt + r) * SC_RS + (32 * kn + 4 * q) * 2;
                    const v2u c0 = *(const LAS v2u*)(cr), c1 = *(const LAS v2u*)(cr + 32);
                    yacc[lt] = __builtin_amdgcn_mfma_f32_16x16x32_bf16(mk8(c0, c1), sb, yacc[lt], 0, 0, 0);
                }
            }
#pragma unroll
            for (int lt = 0; lt < 4; ++lt) { const f32x4 ea = *(const LAS f32x4*)(EA + 16 * lt + 4 * q); yacc[lt] = yacc[lt] * ea; }
#pragma unroll
            for (int rep = 0; rep < 2; ++rep) { const int tile = F.wave + 8 * rep;
                if (tile < 10) { const int tl = tile < 1 ? 0 : (tile < 3 ? 1 : (tile < 6 ? 2 : 3)), ts = tile - (tl * (tl + 1)) / 2;
                    f32x4 cb = (f32x4){0.f, 0.f, 0.f, 0.f};
#pragma unroll
                    for (int kn = 0; kn < 4; ++kn) {
                        const bf16x8 af = *(const LAS bf16x8*)(Bp + (16 * ts + r) * SC_RS + (32 * kn + 8 * q) * 2);
                        const bf16x8 bfr = *(const LAS bf16x8*)(Cp + (16 * tl + r) * SC_RS + (32 * kn + 8 * q) * 2);
                        cb = __builtin_amdgcn_mfma_f32_16x16x32_bf16(af, bfr, cb, 0, 0, 0); }
#pragma unroll
                    for (int h = 0; h < 2; ++h) { const LAS float* Ah = (h == hl) ? ACS : ACSo; const LAS float* Dh = (h == hl) ? DTV : DTVo;
                        const float acl = Ah[16 * tl + r]; const f32x4 as4 = *(const LAS f32x4*)(Ah + 16 * ts + 4 * q), dt4 = *(const LAS f32x4*)(Dh + 16 * ts + 4 * q);
                        f32x4 w;
#pragma unroll
                        for (int i = 0; i < 4; ++i) { const float ex = __expf(fminf(acl - as4[i], 0.f)) * dt4[i]; w[i] = (ts < tl || 4 * q + i <= r) ? cb[i] * ex : 0.f; }
                        *(LAS v2u*)(F.lds + SC_CB + (h * 10 + tile) * 512 + F.lane * 8) = (v2u){pk2c(w[0], w[1]), pk2c(w[2], w[3])}; } } }
            __syncthreads();
            bf16x8 xk[2];
#pragma unroll
            for (int ks = 0; ks < 2; ++ks) { const unsigned ad = Xb + (32 * ks + 4 * q + tq) * SC_RS + (ch0 + 4 * tp) * 2; xk[ks] = lds_tr8(ad, ad + 16 * SC_RS); }
#pragma unroll
            for (int lt = 0; lt < 4; ++lt) {
                v2u wt[4];
#pragma unroll
                for (int st2 = 0; st2 < 4; ++st2) wt[st2] = (st2 <= lt) ? *(const LAS v2u*)(F.lds + SC_CB + (hl * 10 + (lt * (lt + 1)) / 2 + st2) * 512 + F.lane * 8) : (v2u){0u, 0u};
                yacc[lt] = __builtin_amdgcn_mfma_f32_16x16x32_bf16(mk8(wt[0], wt[1]), xk[0], yacc[lt], 0, 0, 0);
                if (lt >= 2) yacc[lt] = __builtin_amdgcn_mfma_f32_16x16x32_bf16(mk8(wt[2], wt[3]), xk[1], yacc[lt], 0, 0, 0);
            }
#pragma unroll
            for (int lt = 0; lt < 4; ++lt) {
                const v2u xv = lds_tr2(Xb + (16 * lt + 4 * q + tq) * SC_RS + (ch0 + 4 * tp) * 2);
                const float x0 = bf_lo(xv.x), x1 = bf_hi(xv.x), x2 = bf_lo(xv.y), x3 = bf_hi(xv.y);
                const f32x4 y = yacc[lt] + (f32x4){x0, x1, x2, x3} * dsk;
                LAS unsigned short* yp = (LAS unsigned short*)(F.lds + SC_YS + (16 * lt + 4 * q) * SC_RS + (ch0 + r) * 2);
                const unsigned p01 = pk2c(y[0], y[1]), p23 = pk2c(y[2], y[3]);
                yp[0] = (unsigned short)(p01 & 0xffffu); yp[SC_RS / 2] = (unsigned short)(p01 >> 16); yp[SC_RS] = (unsigned short)(p23 & 0xffffu); yp[3 * SC_RS / 2] = (unsigned short)(p23 >> 16);
            }
#pragma unroll
            for (int n = 0; n < 8; ++n) S[n] = S[n] * eT;
#pragma unroll
            for (int ks = 0; ks < 2; ++ks) {
                const unsigned xa = Xb + (32 * ks + 8 * q + tq) * SC_RS + (ch0 + 4 * tp) * 2;
                const v2u xa0 = lds_tr2(xa), xa1 = lds_tr2(xa + 4 * SC_RS);
                const f32x4 w0 = *(const LAS f32x4*)(WB + 32 * ks + 8 * q), w1 = *(const LAS f32x4*)(WB + 32 * ks + 8 * q + 4);
                const f32x4 xs0 = (f32x4){bf_lo(xa0.x) * w0[0], bf_hi(xa0.x) * w0[1], bf_lo(xa0.y) * w0[2], bf_hi(xa0.y) * w0[3]};
                const f32x4 xs1 = (f32x4){bf_lo(xa1.x) * w1[0], bf_hi(xa1.x) * w1[1], bf_lo(xa1.y) * w1[2], bf_hi(xa1.y) * w1[3]};
                const bf16x8 xf = pack8(xs0, xs1);
#pragma unroll
                for (int ng = 0; ng < 2; ++ng) {
                    bf16x8 bt[4];
                    lds_tr8x4(Bb + (32 * ks + 8 * q + tq) * SC_RS + (64 * ng + 4 * tp) * 2, bt);
#pragma unroll
                    for (int n4 = 0; n4 < 4; ++n4) S[4 * ng + n4] = __builtin_amdgcn_mfma_f32_16x16x32_bf16(bt[n4], xf, S[4 * ng + n4], 0, 0, 0);
                }
            }
            if (c + 1 < SEQ / 64) { SCM_STORE(st ^ 1); dtc = pdt; dto = pdo; }
            __syncthreads();
            { char* yb = (char*)(YB + t0 * DI + hg0 * HD); const unsigned yo = (unsigned)(((F.tid >> 4) * DI + (F.tid & 15) * 8) * 2);
              unsigned long long* ssp = (unsigned long long*)(a->ws + WS_SS) + ((size_t)j * T + t0) * NG + g;
#pragma unroll
              for (int k = 0; k < 2; ++k) { const int piece = F.tid + 512 * k, row = piece >> 4, c16 = piece & 15;
                const v4u v = *(const LAS v4u*)(F.lds + SC_YS + row * SC_RS + c16 * 16); const v4u zv = zpre[k];
                float hh[8]; float ssq = 0.f;
#pragma unroll
                for (int e = 0; e < 4; ++e) { hh[2 * e] = bf_lo(v[e]) * silu_f(bf_lo(zv[e])); hh[2 * e + 1] = bf_hi(v[e]) * silu_f(bf_hi(zv[e])); ssq += hh[2 * e] * hh[2 * e] + hh[2 * e + 1] * hh[2 * e + 1]; }
                { const int t1 = __builtin_amdgcn_update_dpp(0, __builtin_bit_cast(int, ssq), 0xB1, 0xf, 0xf, false); ssq += __builtin_bit_cast(float, t1); }
                { const int t1 = __builtin_amdgcn_update_dpp(0, __builtin_bit_cast(int, ssq), 0x4E, 0xf, 0xf, false); ssq += __builtin_bit_cast(float, t1); }
                { const int t1 = __builtin_amdgcn_update_dpp(0, __builtin_bit_cast(int, ssq), 0x141, 0xf, 0xf, false); ssq += __builtin_bit_cast(float, t1); }
                { const int t1 = __builtin_amdgcn_update_dpp(0, __builtin_bit_cast(int, ssq), 0x140, 0xf, 0xf, false); ssq += __builtin_bit_cast(float, t1); }
                if (c16 == 0) atomicAdd(ssp + (size_t)row * NG, (unsigned long long)(ssq * 1048576.f + 0.5f));
                v4u ho; ho.x = pk2c(hh[0], hh[1]); ho.y = pk2c(hh[2], hh[3]); ho.z = pk2c(hh[4], hh[5]); ho.w = pk2c(hh[6], hh[7]);
                *(v4u*)(yb + (size_t)k * 32 * DI * 2 + yo) = ho; } }
            __syncthreads();
        }
#undef SCM_LOAD
#undef SCM_STORE
    }
}

__device__ __forceinline__ void ssd_ratio_phase(const Frame& F, KArgs a, int j) {
    const unsigned long long* SS = (const unsigned long long*)(a->ws + WS_SS) + (size_t)j * T * NG; float* RAT = (float*)(a->ws + WS_RAT);
    const size_t gtid = (size_t)blockIdx.x * NTHREADS + F.tid, nthr = (size_t)F.G * NTHREADS;
    for (size_t i = gtid; i < (size_t)T * NG; i += nthr) { const int g = (int)(i & 7);
        const float sc = 1.0f / (1048576.f * 1024.f);
        if (g == 0) RAT[i] = 1.0f / sqrtf((float)SS[i + 7] * sc + RMS_EPS);
        else RAT[i] = sqrtf(((float)SS[i] * sc + RMS_EPS) / ((float)SS[i - 1] * sc + RMS_EPS)); }
}

__device__ __forceinline__ void ssd_gate_phase(const Frame& F, KArgs a, int j) {
    const bf16* ZX = (const bf16*)(a->ws + WS_ZX); const bf16* YB = (const bf16*)(a->ws + WS_YB); bf16* HB = (bf16*)(a->ws + WS_XBC);
    const float* nw = a->in[7] + (size_t)j * DI;
    for (int it0 = F.gw; it0 < T * NG; it0 += 2 * F.NGW) {
        v4u yv[2][2], zv[2][2];
#pragma unroll
        for (int u = 0; u < 2; ++u) { const int it = it0 + u * F.NGW; const int t = it >> 3, g = it & 7, c = g * 1024 + F.lane * 8;
#pragma unroll
            for (int q = 0; q < 2; ++q) { yv[u][q] = *(const v4u*)(YB + (size_t)t * DI + c + 512 * q); zv[u][q] = *(const v4u*)(ZX + (size_t)t * PROJP + c + 512 * q); } }
#pragma unroll
        for (int u = 0; u < 2; ++u) { const int it = it0 + u * F.NGW; const int t = it >> 3, g = it & 7, c = g * 1024 + F.lane * 8;
            float h[16]; float ss = 0.f;
#pragma unroll
            for (int q = 0; q < 2; ++q)
#pragma unroll
                for (int e = 0; e < 4; ++e) { const float y0 = bf_lo(yv[u][q][e]), y1 = bf_hi(yv[u][q][e]), z0 = bf_lo(zv[u][q][e]), z1 = bf_hi(zv[u][q][e]);
                    const float h0 = y0 * silu_f(z0), h1 = y1 * silu_f(z1); h[8 * q + 2 * e] = h0; h[8 * q + 2 * e + 1] = h1; ss += h0 * h0 + h1 * h1; }
            ss = wave_sum(ss);
            const float rstd = 1.0f / sqrtf(ss * (1.0f / 1024.f) + RMS_EPS);
#pragma unroll
            for (int q = 0; q < 2; ++q) {
                const f32x4 w0 = *(const f32x4*)(nw + c + 512 * q), w1 = *(const f32x4*)(nw + c + 512 * q + 4);
                v4u o; o.x = pk2(h[8 * q + 0] * rstd * w0[0], h[8 * q + 1] * rstd * w0[1]); o.y = pk2(h[8 * q + 2] * rstd * w0[2], h[8 * q + 3] * rstd * w0[3]);
                o.z = pk2(h[8 * q + 4] * rstd * w1[0], h[8 * q + 5] * rstd * w1[1]); o.w = pk2(h[8 * q + 6] * rstd * w1[2], h[8 * q + 7] * rstd * w1[3]);
                *(v4u*)(HB + (size_t)t * DI + c + 512 * q) = o;
            }
        }
    }
}

__device__ __forceinline__ void sc_conv_phase(const Frame& F, KArgs a, int j) {
    const bf16* BCH = (const bf16*)(a->ws + WS_ZX); bf16* YC = (bf16*)(a->ws + WS_XBC);
    const float* cw = a->in[10] + (size_t)j * 3 * D;
    constexpr int NCB = D / 512, NITEMS = (T / 32) * NCB, LDB = 3 * D;
    for (int it = F.gw; it < NITEMS; it += F.NGW) {
        const int tb = it / NCB, cbk = it % NCB, c0 = cbk * 512 + F.lane * 8, t0 = tb * 32;
        float w[3][8];
#pragma unroll
        for (int k = 0; k < 3; ++k) { const f32x4 u0 = *(const f32x4*)(cw + (size_t)k * D + c0), u1 = *(const f32x4*)(cw + (size_t)k * D + c0 + 4);
#pragma unroll
            for (int e = 0; e < 4; ++e) { w[k][e] = u0[e]; w[k][4 + e] = u1[e]; } }
        float p0[8], p1[8];
        const bool head = (t0 % SEQ) == 0;
#pragma unroll
        for (int h = 0; h < 2; ++h) {
            v4u gc = (v4u){0u, 0u, 0u, 0u}, hh = (v4u){0u, 0u, 0u, 0u};
            if (!head) { gc = *(const v4u*)(BCH + (size_t)(t0 - 2 + h) * LDB + D + c0); hh = *(const v4u*)(BCH + (size_t)(t0 - 2 + h) * LDB + 2 * D + c0); }
            float* dst = h == 0 ? p0 : p1;
#pragma unroll
            for (int e = 0; e < 4; ++e) { dst[2 * e] = bf_lo(gc[e]) * bf_lo(hh[e]); dst[2 * e + 1] = bf_hi(gc[e]) * bf_hi(hh[e]); }
        }
        for (int tt0 = 0; tt0 < 32; tt0 += 4) {
            v4u gbv[4], gcv[4], hhv[4];
#pragma unroll
            for (int k = 0; k < 4; ++k) { const bf16* rowp = BCH + (size_t)(t0 + tt0 + k) * LDB + c0; gbv[k] = __builtin_nontemporal_load((const v4u*)(rowp)); gcv[k] = __builtin_nontemporal_load((const v4u*)(rowp + D)); hhv[k] = __builtin_nontemporal_load((const v4u*)(rowp + 2 * D)); }
#pragma unroll
            for (int k = 0; k < 4; ++k) {
                const v4u gb = gbv[k], gc = gcv[k], hh = hhv[k];
                float cur[8], o[8], gbf[8];
#pragma unroll
                for (int e = 0; e < 4; ++e) { cur[2 * e] = bf_lo(gc[e]) * bf_lo(hh[e]); cur[2 * e + 1] = bf_hi(gc[e]) * bf_hi(hh[e]); gbf[2 * e] = bf_lo(gb[e]); gbf[2 * e + 1] = bf_hi(gb[e]); }
#pragma unroll
                for (int e = 0; e < 8; ++e) { o[e] = gbf[e] * (w[0][e] * p0[e] + w[1][e] * p1[e] + w[2][e] * cur[e]); p0[e] = p1[e]; p1[e] = cur[e]; }
                v4u ov; ov.x = pk2(o[0], o[1]); ov.y = pk2(o[2], o[3]); ov.z = pk2(o[4], o[5]); ov.w = pk2(o[6], o[7]);
                __builtin_nontemporal_store(ov, (v4u*)(YC + (size_t)(t0 + tt0 + k) * D + c0));
            }
        }
    }
}

__device__ __forceinline__ void ln_phase(const Frame& F, const float* Y32, float* X32, bf16* XB, const float* gam, const float* bet) {
    for (int m = F.gw; m < T; m += F.NGW) {
        const f32x4* xr = (const f32x4*)(Y32 + (size_t)m * D) + F.lane;
        f32x4 v[16]; float s = 0.f;
#pragma unroll
        for (int q = 0; q < 16; ++q) { v[q] = xr[64 * q]; s += (v[q][0] + v[q][1]) + (v[q][2] + v[q][3]); }
        const float mean = wave_sum(s) * (1.f / D); float s2 = 0.f;
#pragma unroll
        for (int q = 0; q < 16; ++q) { v[q] = v[q] - mean; s2 += (v[q][0] * v[q][0] + v[q][1] * v[q][1]) + (v[q][2] * v[q][2] + v[q][3] * v[q][3]); }
        const float rstd = 1.f / sqrtf(wave_sum(s2) * (1.f / D) + LN_EPS);
        f32x4* o4 = (f32x4*)(X32 + (size_t)m * D) + F.lane; unsigned long long* o8 = (unsigned long long*)(XB + (size_t)m * D) + F.lane;
#pragma unroll
        for (int q = 0; q < 16; ++q) { const f32x4 gg = ((const f32x4*)gam)[F.lane + 64 * q], bb = ((const f32x4*)bet)[F.lane + 64 * q];
            const f32x4 o = v[q] * rstd * gg + bb; o4[64 * q] = o;
            o8[64 * q] = (unsigned long long)pk2(o[0], o[1]) | ((unsigned long long)pk2(o[2], o[3]) << 32); }
    }
}

constexpr int TK_TAB = RING_BYTES + 1024;
__device__ __forceinline__ unsigned f2sort(float f) { const unsigned u = __float_as_uint(f); return u ^ (((int)u >> 31) | 0x80000000u); }
__device__ __forceinline__ float sort2f(unsigned k) { const unsigned u = (k & 0x80000000u) ? (k ^ 0x80000000u) : ~k; return __uint_as_float(u); }
#define DPP_UMAX_ROW(v) do { \
    { const unsigned t_ = (unsigned)__builtin_amdgcn_update_dpp((int)(v), (int)(v), 0xB1, 0xf, 0xf, false); v = v > t_ ? v : t_; } \
    { const unsigned t_ = (unsigned)__builtin_amdgcn_update_dpp((int)(v), (int)(v), 0x4E, 0xf, 0xf, false); v = v > t_ ? v : t_; } \
    { const unsigned t_ = (unsigned)__builtin_amdgcn_update_dpp((int)(v), (int)(v), 0x141, 0xf, 0xf, false); v = v > t_ ? v : t_; } \
    { const unsigned t_ = (unsigned)__builtin_amdgcn_update_dpp((int)(v), (int)(v), 0x140, 0xf, 0xf, false); v = v > t_ ? v : t_; } } while (0)
#define DPP_FADD_ROW(v) do { \
    { const int t_ = __builtin_amdgcn_update_dpp(0, __builtin_bit_cast(int, v), 0xB1, 0xf, 0xf, false); v += __builtin_bit_cast(float, t_); } \
    { const int t_ = __builtin_amdgcn_update_dpp(0, __builtin_bit_cast(int, v), 0x4E, 0xf, 0xf, false); v += __builtin_bit_cast(float, t_); } \
    { const int t_ = __builtin_amdgcn_update_dpp(0, __builtin_bit_cast(int, v), 0x141, 0xf, 0xf, false); v += __builtin_bit_cast(float, t_); } \
    { const int t_ = __builtin_amdgcn_update_dpp(0, __builtin_bit_cast(int, v), 0x140, 0xf, 0xf, false); v += __builtin_bit_cast(float, t_); } } while (0)
__device__ __forceinline__ void peer_topk_phase(const Frame& F, KArgs a, int layer) {
    const float* Q32 = (const float*)(a->ws + WS_Q32); int* EIDX = (int*)(a->ws + WS_EIDX); float* GATES = (float*)(a->ws + WS_GATES);
    LAS float* KT = (LAS float*)F.lds;
    LAS unsigned char* TAB = (LAS unsigned char*)(F.lds + TK_TAB);
    const int r = F.lane & 15, q = F.lane >> 4, rowbase = F.lane & 48;
    if (F.tid < 64) { int n = 0, ca = 0, cb = 0; for (int aa = 0; aa < PK; ++aa) for (int bb = 0; bb < PK; ++bb) if ((aa + 1) * (bb + 1) <= PK) { if (n == F.tid) { ca = aa; cb = bb; } ++n; }
        TAB[F.tid] = (unsigned char)ca; TAB[64 + F.tid] = (unsigned char)cb; }
    __syncthreads();
    int cda[4], cdb[4];
#pragma unroll
    for (int c = 0; c < 4; ++c) { cda[c] = TAB[4 * r + c]; cdb[c] = TAB[64 + 4 * r + c]; }
    for (int unit = blockIdx.x; unit < PH * 32; unit += F.G) {
        const int h = unit >> 5, tr = unit & 31;
        const char* keys = (const char*)(a->in[13] + ((size_t)(layer * PH + h) * 2) * NK * HALFD);
        unsigned kvo = (unsigned)(((F.tid >> 4) * HALFD + (F.tid & 15) * 8) * 4); asm volatile("" : "+v"(kvo));
        __syncthreads();
#pragma unroll
        for (int i = 0; i < 2; ++i)
#pragma unroll
            for (int itx = 0; itx < 4; ++itx) { const int key = itx * 32 + (F.tid >> 4), ch = F.tid & 15;
                const f32x4 v0 = *(const f32x4*)(keys + (size_t)(i * NK * HALFD * 4 + itx * 32 * HALFD * 4) + kvo), v1 = *(const f32x4*)(keys + (size_t)(i * NK * HALFD * 4 + itx * 32 * HALFD * 4 + 16) + kvo);
                v4u hi, lo;
                hi.x = pk2c(v0[0], v0[1]); hi.y = pk2c(v0[2], v0[3]); hi.z = pk2c(v1[0], v1[1]); hi.w = pk2c(v1[2], v1[3]);
                lo.x = pk2c(v0[0] - bf_lo(hi.x), v0[1] - bf_hi(hi.x)); lo.y = pk2c(v0[2] - bf_lo(hi.y), v0[3] - bf_hi(hi.y)); lo.z = pk2c(v1[0] - bf_lo(hi.z), v1[1] - bf_hi(hi.z)); lo.w = pk2c(v1[2] - bf_lo(hi.w), v1[3] - bf_hi(hi.w));
                const int off = i * 32768 + key * 256 + ((ch ^ (key & 15)) << 4);
                *(LAS v4u*)(F.lds + off) = hi; *(LAS v4u*)(F.lds + 65536 + off) = lo; }
        __syncthreads();
        unsigned qvo = (unsigned)((r * QD + 8 * q) * 4); asm volatile("" : "+v"(qvo));
        const unsigned ovo = (unsigned)(((4 * q) * (PH * PK) + r) * 4);
        for (int batch = 0; batch < 4; ++batch) {
            const int t0 = tr * 512 + F.wave * 64 + batch * 16;
            f32x4 acc[2][8];
#pragma unroll
            for (int i = 0; i < 2; ++i) {
                const char* qp = (const char*)(Q32 + (size_t)t0 * QD + h * 256 + i * 128);
#pragma unroll
                for (int nt = 0; nt < 8; ++nt) acc[i][nt] = (f32x4){0.f, 0.f, 0.f, 0.f};
#pragma unroll
                for (int ks = 0; ks < 4; ++ks) {
                    const f32x4 q0 = *(const f32x4*)(qp + 128 * ks + qvo), q1 = *(const f32x4*)(qp + 128 * ks + 16 + qvo);
                    v4u ah, al;
                    ah.x = pk2c(q0[0], q0[1]); ah.y = pk2c(q0[2], q0[3]); ah.z = pk2c(q1[0], q1[1]); ah.w = pk2c(q1[2], q1[3]);
                    al.x = pk2c(q0[0] - bf_lo(ah.x), q0[1] - bf_hi(ah.x)); al.y = pk2c(q0[2] - bf_lo(ah.y), q0[3] - bf_hi(ah.y)); al.z = pk2c(q1[0] - bf_lo(ah.z), q1[1] - bf_hi(ah.z)); al.w = pk2c(q1[2] - bf_lo(ah.w), q1[3] - bf_hi(ah.w));
                    const bf16x8 Ah = __builtin_bit_cast(bf16x8, ah), Al = __builtin_bit_cast(bf16x8, al);
#pragma unroll
                    for (int nt = 0; nt < 8; ++nt) {
                        const int off = i * 32768 + (16 * nt + r) * 256 + (((4 * ks + q) ^ r) << 4);
                        const bf16x8 Bh = *(const LAS bf16x8*)(F.lds + off), Bl = *(const LAS bf16x8*)(F.lds + 65536 + off);
                        acc[i][nt] = __builtin_amdgcn_mfma_f32_16x16x32_bf16(Ah, Bh, acc[i][nt], 0, 0, 0);
                        acc[i][nt] = __builtin_amdgcn_mfma_f32_16x16x32_bf16(Al, Bh, acc[i][nt], 0, 0, 0);
                        acc[i][nt] = __builtin_amdgcn_mfma_f32_16x16x32_bf16(Ah, Bl, acc[i][nt], 0, 0, 0);
                    }
                    __builtin_amdgcn_sched_barrier(0);
                }
            }
#pragma unroll
            for (int e = 0; e < 4; ++e) {
                unsigned res[2];
#pragma unroll
                for (int i = 0; i < 2; ++i) {
                    unsigned key[8];
#pragma unroll
                    for (int nt = 0; nt < 8; ++nt) key[nt] = (f2sort(acc[i][nt][e]) & ~127u) | (unsigned)(127 - (16 * nt + r));
#define TK_CE(i_, j_) do { const unsigned hi_ = key[i_] > key[j_] ? key[i_] : key[j_], lo_ = key[i_] > key[j_] ? key[j_] : key[i_]; key[i_] = hi_; key[j_] = lo_; } while (0)
                    TK_CE(0, 1); TK_CE(2, 3); TK_CE(4, 5); TK_CE(6, 7); TK_CE(0, 2); TK_CE(1, 3); TK_CE(4, 6); TK_CE(5, 7); TK_CE(1, 2); TK_CE(5, 6);
                    TK_CE(0, 4); TK_CE(1, 5); TK_CE(2, 6); TK_CE(3, 7); TK_CE(2, 4); TK_CE(3, 5); TK_CE(1, 2); TK_CE(3, 4); TK_CE(5, 6);
#undef TK_CE
                    unsigned rs = 0u;
                    for (int step = 0; step < PK; ++step) {
                        unsigned m = key[0];
                        DPP_UMAX_ROW(m);
                        const bool won = (key[0] == m);
#pragma unroll
                        for (int nt = 0; nt < 7; ++nt) key[nt] = won ? key[nt + 1] : key[nt];
                        key[7] = won ? 0u : key[7];
                        rs = (r == step) ? m : rs;
                    }
                    res[i] = rs;
                }
                unsigned ck[4];
#pragma unroll
                for (int c = 0; c < 4; ++c) { const unsigned k1 = (unsigned)__shfl((int)res[0], rowbase + cda[c]), k2 = (unsigned)__shfl((int)res[1], rowbase + cdb[c]);
                    const float sv = sort2f(k1 & ~127u) + sort2f(k2 & ~127u); const int cid = 4 * r + c;
                    ck[c] = (cid < 50) ? ((f2sort(sv) & ~63u) | (unsigned)(63 - cid)) : 0u; }
#define TK_CE(i_, j_) do { const unsigned hi_ = ck[i_] > ck[j_] ? ck[i_] : ck[j_], lo_ = ck[i_] > ck[j_] ? ck[j_] : ck[i_]; ck[i_] = hi_; ck[j_] = lo_; } while (0)
                TK_CE(0, 1); TK_CE(2, 3); TK_CE(0, 2); TK_CE(1, 3); TK_CE(1, 2);
#undef TK_CE
                unsigned rs3 = 0u;
                for (int step = 0; step < PK; ++step) {
                    unsigned m = ck[0];
                    DPP_UMAX_ROW(m);
                    const bool won = (ck[0] == m);
                    ck[0] = won ? ck[1] : ck[0]; ck[1] = won ? ck[2] : ck[1]; ck[2] = won ? ck[3] : ck[2]; ck[3] = won ? 0u : ck[3];
                    rs3 = (r == step) ? m : rs3;
                }
                const int cid = 63 - (int)(rs3 & 63u); const float tv = sort2f(rs3 & ~63u);
                const int ta = TAB[cid], tb = TAB[64 + cid];
                const int i1 = 127 - (int)((unsigned)__shfl((int)res[0], rowbase + ta) & 127u), i2 = 127 - (int)((unsigned)__shfl((int)res[1], rowbase + tb) & 127u);
                const float mx = __shfl(tv, rowbase);
                const float ex = __expf(tv - mx); float sum = ex; DPP_FADD_ROW(sum);
                { char* ep = (char*)(EIDX + ((size_t)(t0 + e) * PH + h) * PK); char* gp = (char*)(GATES + ((size_t)(t0 + e) * PH + h) * PK);
                  *(int*)(ep + ovo) = i1 * NK + i2; *(float*)(gp + ovo) = ex / sum; }
            }
        }
    }
}

__device__ __forceinline__ float gelu_as(float v) {
    const float av = fabsf(v), t = __builtin_amdgcn_rcpf(av * 0.2316418882f + 1.0f);
    float q = t * 0.5307027145f + (-0.7265760135f); q = q * t + 0.7107068705f; q = q * t + (-0.142248368f); q = q * t + 0.127414796f; q = q * t;
    const float m = v * (q * __builtin_amdgcn_exp2f((v * v) * (-0.72134752044f)));
    return v < 0.f ? m : v - m;
}
#define FP4X2(w, b) __builtin_amdgcn_cvt_scalef32_pk_f32_fp4((w), 1.0f, (b))
__device__ __forceinline__ void peer_gather_phase(const Frame& F, KArgs a, int layer) {
    const char* U = (const char*)(a->ws + WS_W_U) + (size_t)layer * NEXP * D; const char* V = U + (D / 2);
    const float* RSU = (const float*)(a->ws + WS_RS) + (size_t)layer * NEXP; const float* RSV = RSU + 4 * NEXP;
    const int* EIDX = (const int*)(a->ws + WS_EIDX); const float* GATES = (const float*)(a->ws + WS_GATES);
    char* X32 = (char*)(a->ws + WS_X32); char* XB = (char*)(a->ws + WS_XB);
    const char* gam = (const char*)(a->in[18] + (size_t)layer * D); const char* bet = (const char*)(a->in[19] + (size_t)layer * D);
    const bool lastl = (layer == DEPTH - 1);
    char* OUT = lastl ? (char*)a->out : X32;
    const char* YBF = (const char*)(a->ws + WS_YBF);
    const int* S1 = (const int*)((const float*)(a->ws + WS_CTL) + CW_ST + layer * 2 * T); const int* S2 = S1 + T;
    LAS float* G1 = (LAS float*)F.lds; LAS float* B1 = G1 + D;
    __syncthreads();
    for (int i = F.tid; i < D / 4; i += NTHREADS) { ((LAS f32x4*)G1)[i] = ((const f32x4*)(a->in[16] + (size_t)layer * D))[i]; ((LAS f32x4*)B1)[i] = ((const f32x4*)(a->in[17] + (size_t)layer * D))[i]; }
    __syncthreads();
    for (int t = F.gw, trip = 0; trip < (T + F.NGW - 1) / F.NGW; ++trip, t += F.NGW) {
        __syncthreads();
        if (t >= T) continue;
        unsigned lo16 = F.lane * 16u; asm volatile("" : "+v"(lo16));
        const unsigned lo128 = lo16 * 8u;
        const char* xrow = YBF + (size_t)t * D * 2;
        const float mu1 = (float)S1[t] * (1.0f / (65536.f * D)); const float rs1 = 1.0f / sqrtf(fmaxf((float)S2[t] * (1.0f / (4096.f * D)) - mu1 * mu1, 0.f) + LN_EPS);
        f32x2 xp[32];
#pragma unroll
        for (int i = 0; i < 2; ++i)
#pragma unroll
            for (int k = 0; k < 8; ++k) { const v2u qb = *(const v2u*)(xrow + i * 4096 + k * 512 + (lo16 >> 1)); const f32x4 q = (f32x4){bf_lo(qb.x), bf_hi(qb.x), bf_lo(qb.y), bf_hi(qb.y)};
                const f32x4 gq = *(const LAS f32x4*)((const LAS char*)G1 + i * 8192 + k * 1024 + lo16), bq = *(const LAS f32x4*)((const LAS char*)B1 + i * 8192 + k * 1024 + lo16);
                const f32x4 xv = (q - mu1) * rs1 * gq + bq; xp[i * 16 + 2 * k] = (f32x2){xv[0], xv[1]}; xp[i * 16 + 2 * k + 1] = (f32x2){xv[2], xv[3]}; }
        int ev0 = EIDX[(size_t)t * 128 + F.lane], ev1 = EIDX[(size_t)t * 128 + 64 + F.lane];
        float gv0 = GATES[(size_t)t * 128 + F.lane], gv1 = GATES[(size_t)t * 128 + 64 + F.lane];
        {
            int r0 = 0, r1 = 0;
            for (int jx = 0; jx < 64; ++jx) { const int ea = __builtin_amdgcn_readlane(ev0, jx), eb = __builtin_amdgcn_readlane(ev1, jx);
                r0 += (ea < ev0 || (ea == ev0 && jx < F.lane)) ? 1 : 0; r0 += (eb < ev0) ? 1 : 0;
                r1 += (ea < ev1 || ea == ev1) ? 1 : 0; r1 += (eb < ev1 || (eb == ev1 && jx < F.lane)) ? 1 : 0; }
            LAS int* se = (LAS int*)(F.lds + 32768 + F.wave * 1024); LAS float* sg = (LAS float*)(se + 128);
            se[r0] = ev0; sg[r0] = gv0; se[r1] = ev1; sg[r1] = gv1;
            asm volatile("s_waitcnt lgkmcnt(0)" ::: "memory");
            ev0 = se[F.lane]; ev1 = se[64 + F.lane]; gv0 = sg[F.lane]; gv1 = sg[64 + F.lane];
        }
        f32x2 ap[32];
#pragma unroll
        for (int k = 0; k < 32; ++k) ap[k] = (f32x2){0.f, 0.f};
        const float su0 = RSU[ev0], su1 = RSU[ev1]; gv0 *= RSV[ev0]; gv1 *= RSV[ev1];
#define GROW_LOAD(q, jn) do { const int en_ = __builtin_amdgcn_readlane((jn) < 64 ? ev0 : ev1, (jn) & 63); \
            const char* ur_ = U + (size_t)en_ * D; unsigned lo_ = lo16; asm volatile("" : "+v"(lo_)); uu[q][0] = *(const v4u*)(ur_ + lo_); uu[q][1] = *(const v4u*)(ur_ + 1024 + lo_); vv[q][0] = *(const v4u*)(ur_ + 2048 + lo_); vv[q][1] = *(const v4u*)(ur_ + 3072 + lo_); } while (0)
        v4u uu[4][2], vv[4][2]; float dep = 0.f;
#pragma unroll
        for (int q = 0; q < 4; ++q) GROW_LOAD(q, q);
        for (int jb = 0; jb < 32; ++jb) {
#pragma unroll
            for (int q = 0; q < 4; ++q) { const int jj = jb * 4 + q;
                const float gt = __builtin_bit_cast(float, __builtin_amdgcn_readlane(__builtin_bit_cast(int, jj < 64 ? gv0 : gv1), jj & 63));
                const float su = __builtin_bit_cast(float, __builtin_amdgcn_readlane(__builtin_bit_cast(int, jj < 64 ? su0 : su1), jj & 63));
                f32x2 s0 = (f32x2){0.f, 0.f}, s1 = (f32x2){0.f, 0.f};
#pragma unroll
                for (int i = 0; i < 2; ++i) { const v4u w4 = uu[q][i];
                    s0 += FP4X2(w4.x, 0) * xp[i * 16 + 0];  s1 += FP4X2(w4.x, 1) * xp[i * 16 + 1];  s0 += FP4X2(w4.x, 2) * xp[i * 16 + 2];  s1 += FP4X2(w4.x, 3) * xp[i * 16 + 3];
                    s0 += FP4X2(w4.y, 0) * xp[i * 16 + 4];  s1 += FP4X2(w4.y, 1) * xp[i * 16 + 5];  s0 += FP4X2(w4.y, 2) * xp[i * 16 + 6];  s1 += FP4X2(w4.y, 3) * xp[i * 16 + 7];
                    s0 += FP4X2(w4.z, 0) * xp[i * 16 + 8];  s1 += FP4X2(w4.z, 1) * xp[i * 16 + 9];  s0 += FP4X2(w4.z, 2) * xp[i * 16 + 10]; s1 += FP4X2(w4.z, 3) * xp[i * 16 + 11];
                    s0 += FP4X2(w4.w, 0) * xp[i * 16 + 12]; s1 += FP4X2(w4.w, 1) * xp[i * 16 + 13]; s0 += FP4X2(w4.w, 2) * xp[i * 16 + 14]; s1 += FP4X2(w4.w, 3) * xp[i * 16 + 15]; }
                float hq = wave_sum((s0[0] + s0[1]) + (s1[0] + s1[1])) * su; asm volatile("" : "+v"(hq) : "v"(dep));
                const float act = gelu_as(hq) * gt; dep = act;
                const f32x2 a2 = (f32x2){act, act};
                __builtin_amdgcn_sched_barrier(0);
#pragma unroll
                for (int i = 0; i < 2; ++i) { const v4u w4 = vv[q][i];
                    ap[i * 16 + 0] += a2 * FP4X2(w4.x, 0);  ap[i * 16 + 1] += a2 * FP4X2(w4.x, 1);  ap[i * 16 + 2] += a2 * FP4X2(w4.x, 2);  ap[i * 16 + 3] += a2 * FP4X2(w4.x, 3);
                    ap[i * 16 + 4] += a2 * FP4X2(w4.y, 0);  ap[i * 16 + 5] += a2 * FP4X2(w4.y, 1);  ap[i * 16 + 6] += a2 * FP4X2(w4.y, 2);  ap[i * 16 + 7] += a2 * FP4X2(w4.y, 3);
                    __builtin_amdgcn_sched_barrier(0);
                    ap[i * 16 + 8] += a2 * FP4X2(w4.z, 0);  ap[i * 16 + 9] += a2 * FP4X2(w4.z, 1);  ap[i * 16 + 10] += a2 * FP4X2(w4.z, 2); ap[i * 16 + 11] += a2 * FP4X2(w4.z, 3);
                    ap[i * 16 + 12] += a2 * FP4X2(w4.w, 0); ap[i * 16 + 13] += a2 * FP4X2(w4.w, 1); ap[i * 16 + 14] += a2 * FP4X2(w4.w, 2); ap[i * 16 + 15] += a2 * FP4X2(w4.w, 3);
                    __builtin_amdgcn_sched_barrier(0); }
                { const int jn = jj + 4 < 128 ? jj + 4 : 127; GROW_LOAD(q, jn); }
                __builtin_amdgcn_sched_barrier(0);
            }
        }
#undef GROW_LOAD
        f32x2 sp = (f32x2){0.f, 0.f};
#pragma unroll
        for (int k = 0; k < 32; ++k) { ap[k] += xp[k] * ALPHA; sp += ap[k]; }
        const float mean = wave_sum(sp[0] + sp[1]) * (1.f / D); f32x2 s2 = (f32x2){0.f, 0.f};
#pragma unroll
        for (int k = 0; k < 32; ++k) { ap[k] -= mean; s2 += ap[k] * ap[k]; }
        const float rstd = 1.f / sqrtf(wave_sum(s2[0] + s2[1]) * (1.f / D) + LN_EPS);
        char* orow = OUT + (size_t)t * D * 4; char* obrow = XB + (size_t)t * D * 2;
        const unsigned lo64 = lo16 * 4u;
#pragma unroll
        for (int i = 0; i < 2; ++i) {
#pragma unroll
            for (int kk = 0; kk < 8; ++kk) {
                const f32x4 g = *(const f32x4*)(gam + i * 8192 + kk * 1024 + lo16), b = *(const f32x4*)(bet + i * 8192 + kk * 1024 + lo16);
                const f32x2 o0 = ap[i * 16 + 2 * kk] * rstd * (f32x2){g[0], g[1]} + (f32x2){b[0], b[1]}, o1 = ap[i * 16 + 2 * kk + 1] * rstd * (f32x2){g[2], g[3]} + (f32x2){b[2], b[3]};
                if (lastl) *(f32x4*)(orow + i * 8192 + kk * 1024 + lo16) = (f32x4){o0[0], o0[1], o1[0], o1[1]};
                else *(v2u*)(obrow + i * 4096 + kk * 512 + (lo16 >> 1)) = (v2u){pk2(o0[0], o0[1]), pk2(o1[0], o1[1])};
                if ((kk & 3) == 3) asm volatile("" ::: "memory");
            }
        }
    }
}

constexpr int NPHASE = 1 + 10 * DEPTH;
__global__ void __launch_bounds__(NTHREADS, 2) mk_fwd(Args args) {
    extern __shared__ __attribute__((aligned(16))) unsigned char lds[];
    Frame F;
#define NEWFRAME() do { int t_ = threadIdx.x; asm volatile("" : "+v"(t_)); F.lds = (LAS unsigned char*)lds; F.tid = t_; F.lane = t_ & 63; F.wave = __builtin_amdgcn_readfirstlane(t_ >> 6); \
        F.G = gridDim.x; F.gw = blockIdx.x * NWAVES + F.wave; F.NGW = F.G * NWAVES; } while (0)
    NEWFRAME();
    for (int u = F.tid; u < (LDS_BYTES - LDSCTL_OFF) / 4; u += NTHREADS) ((LAS unsigned*)(F.lds + LDSCTL_OFF))[u] = 0u;
    __syncthreads();
    volatile LAS unsigned* MISC = (volatile LAS unsigned*)(F.lds + MISC_OFF);
    if (args.use_bar) (void)xcd_barrier_post((unsigned*)(KA()->ws + WS_CTL) + CW_BAR, MISC + 8);
    const int lo = args.ph_lo, hi = args.ph_hi;
#define IN(k) (lo <= (k) && (k) < hi)
#define SEAM(k) do { if (args.use_bar && (k) + 1 < hi) { XcdBarrier bar_; bar_.bar = (unsigned*)(KA()->ws + WS_CTL) + CW_BAR; bar_.x = xb_xcc_id(); bar_.st = (volatile LAS unsigned*)((LAS unsigned char*)lds + MISC_OFF) + 8; xcd_barrier(bar_); } } while (0)

    if (IN(0)) { NEWFRAME(); p0_prologue(F, KA()); SEAM(0); }

    for (int layer = 0; layer < DEPTH; ++layer) {
        const int pb = 1 + 10 * layer, j = layer >> 1;

        if ((layer & 1) == 0) {
            if (IN(pb + 0)) {
                unsigned char* ws = KA()->ws; pg8::Gemm g{(const bf16*)(ws + WS_XB), (const bf16*)(ws + WS_W_SSD_IN + j * SZ_W_SSD_IN), T, PROJM, D, D}; pg8::StaticOrder S; S.init(T, PROJM, F.G, (int)blockIdx.x);
                pg8::EpiBf16 E{(bf16*)(ws + WS_ZX), PROJP};
                pg8::gemm_phase<pg8::EpiBf16, pg8::StaticOrder, true, true>(F.lds, g, S, E);
                {
                    unsigned char* ws2 = KA()->ws; pg8::Gemm g2{(const bf16*)(ws2 + WS_XB), (const bf16*)(ws2 + WS_W_SSD_IN + j * SZ_W_SSD_IN) + (size_t)PROJM * D, T, 256, D / 4, D};
                    pg8::SplitK4Order S2; S2.init(T, D / 4, F.G, (int)blockIdx.x); pg8::EpiDt E2{j};
                    pg8::gemm_phase<pg8::EpiDt, pg8::SplitK4Order, true, true>(F.lds, g2, S2, E2); }
                SEAM(pb + 0);
            }
            if (IN(pb + 1)) { NEWFRAME(); ssd_conv_phase(F, KA(), j); SEAM(pb + 1); }
            if (IN(pb + 2)) { NEWFRAME(); ssd_scan_mfma_phase(F, KA(), j); SEAM(pb + 2); }
            if (IN(pb + 3)) { NEWFRAME(); ssd_ratio_phase(F, KA(), j); SEAM(pb + 3); }
            if (IN(pb + 4)) {
                unsigned char* ws = KA()->ws; pg8::Gemm g{(const bf16*)(ws + WS_YB), (const bf16*)(ws + WS_W_SSD_OUT + j * SZ_W_SSD_OUT), T, D, DI / NG, DI}; pg8::Group8Order S; S.init(T, D, F.G, (int)blockIdx.x, DI / NG);
                pg8::EpiResS<true> E{layer, D, ALPHA};
                pg8::gemm_phase<pg8::EpiResS<true>, pg8::Group8Order, true, true>(F.lds, g, S, E);
                SEAM(pb + 4);
            }
        } else {
            if (IN(pb + 0)) {
                unsigned char* ws = KA()->ws; pg8::Gemm g{(const bf16*)(ws + WS_XB), (const bf16*)(ws + WS_W_SC_IN + j * SZ_W_SC_IN), T, 3 * D, D, D}; pg8::StaticOrder S; S.init(T, 3 * D, F.G, (int)blockIdx.x);
                pg8::EpiBf16 E{(bf16*)(ws + WS_ZX), 3 * D};
                pg8::gemm_phase<pg8::EpiBf16, pg8::StaticOrder, true, true>(F.lds, g, S, E);
                SEAM(pb + 0);
            }
            if (IN(pb + 1)) { NEWFRAME(); sc_conv_phase(F, KA(), j); SEAM(pb + 1); }
            if (IN(pb + 4)) {
                unsigned char* ws = KA()->ws; pg8::Gemm g{(const bf16*)(ws + WS_XBC), (const bf16*)(ws + WS_W_SC_OUT + j * SZ_W_SC_OUT), T, D, D, D}; pg8::StaticOrder S; S.init(T, D, F.G, (int)blockIdx.x);
                pg8::EpiResS<false> E{layer, D, ALPHA};
                pg8::gemm_phase<pg8::EpiResS<false>, pg8::StaticOrder, true, true>(F.lds, g, S, E);
                SEAM(pb + 4);
            }
        }
        if (IN(pb + 6)) {
            unsigned char* ws = KA()->ws; pg8::Gemm g{(const bf16*)(ws + WS_YBF), (const bf16*)(ws + WS_W_WQ + layer * SZ_W_WQ), T, QD, D, D}; pg8::StaticOrder S; S.init(T, QD, F.G, (int)blockIdx.x);
            pg8::EpiQ E{layer, QD, 1.0f / D, LN_EPS};
            pg8::gemm_phase<pg8::EpiQ, pg8::StaticOrder, true, true>(F.lds, g, S, E);
            SEAM(pb + 6);
        }
        if (IN(pb + 7)) { NEWFRAME(); peer_topk_phase(F, KA(), layer); SEAM(pb + 7); }
        if (IN(pb + 8)) { NEWFRAME(); peer_gather_phase(F, KA(), layer); SEAM(pb + 8); }
    }
#undef IN
#undef SEAM
#undef NEWFRAME
}

static bool phase_exists(int p) {
    if (p == 0) return true;
    const int layer = (p - 1) / 10, k = (p - 1) % 10;
    if (k == 9 || k == 5) return false;
    if ((layer & 1) && (k == 2 || k == 3)) return false;
    return true;
}
extern "C" void kernel_launch(void* const* d_in, const int* in_sizes, int n_in, void* d_out, int out_size, void* d_ws, size_t ws_size, hipStream_t stream) {
    static int grid = 0;
    if (grid == 0) {
        if (n_in != 20 || out_size != T * D || ws_size < WS_END) { fprintf(stderr, "kernel_launch: unexpected shapes (n_in %d out %d ws %zu need %zu)\n", n_in, out_size, ws_size, (size_t)WS_END); grid = -1; return; }
        int dev = 0, cus = 0;
        if (hipGetDevice(&dev) != hipSuccess || hipDeviceGetAttribute(&cus, hipDeviceAttributeMultiprocessorCount, dev) != hipSuccess) { grid = -1; return; }
        if (hipFuncSetAttribute((const void*)mk_fwd, hipFuncAttributeMaxDynamicSharedMemorySize, LDS_BYTES) != hipSuccess) { fprintf(stderr, "kernel_launch: hipFuncSetAttribute failed\n"); grid = -1; return; }
        int per_cu = 0;
        if (hipOccupancyMaxActiveBlocksPerMultiprocessor(&per_cu, (const void*)mk_fwd, NTHREADS, LDS_BYTES) != hipSuccess || per_cu < 1) { fprintf(stderr, "kernel_launch: occupancy query says %d\n", per_cu); (void)hipGetLastError(); grid = -1; return; }
        grid = cus;
    }
    if (grid < 0) return;
    (void)hipMemsetAsync((char*)d_ws + WS_CTL, 0, CTL_ZERO_BYTES, stream);
    (void)hipMemsetAsync((char*)d_ws + WS_DTACC, 0, (size_t)2 * T * NH * 4 + (size_t)2 * T * NG * 8, stream);
    Args a{};
    for (int i = 0; i < 20; ++i) a.in[i] = (const float*)d_in[i];
    a.out = (float*)d_out; a.ws = (unsigned char*)d_ws; a.pad = 0;
#if MK_MULTI
    for (int p = 0; p < NPHASE; ++p) { if (!phase_exists(p)) continue; a.ph_lo = p; a.ph_hi = p + 1; a.use_bar = 0;
        hipLaunchKernelGGL(mk_fwd, dim3(grid), dim3(NTHREADS), LDS_BYTES, stream, a); }
#else
    a.ph_lo = 0; a.ph_hi = NPHASE; a.use_bar = 1;
    hipLaunchKernelGGL(mk_fwd, dim3(grid), dim3(NTHREADS), LDS_BYTES, stream, a);
#endif
}
```

```cpp
#include <hip/hip_runtime.h>
#include <cstdio>
#include <cstdint>

#ifndef MK_DBG
#define MK_DBG 0
#endif
#ifndef MK_MULTI
#define MK_MULTI 0
#endif

namespace pg8 {
#define PG8_LAS __attribute__((address_space(3)))
typedef unsigned short bf16_t;
typedef short bf16x8 __attribute__((ext_vector_type(8)));
typedef float f32x4 __attribute__((ext_vector_type(4)));
typedef unsigned u32x4 __attribute__((ext_vector_type(4)));
constexpr int BM = 256, BK = 64, HALF = 128, HTB = HALF * BK * 2, STAGE_BYTES = 8 * HTB, NXCD = 8, WGM = 8;

__host__ __device__ __forceinline__ int lds_byte(int r, int c) { const int st = (r >> 4) * 2 + (c >> 5), rr = r & 15, cc = c & 31, ob = rr * 64 + cc * 2; return st * 1024 + (ob ^ (((ob >> 9) & 1) << 5)); }
__host__ __device__ __forceinline__ void stage_rc(int b, int& R, int& C) { const int st = b / 1024, sb = b % 1024, swz = sb ^ (((sb >> 9) & 1) << 5); R = (st >> 1) * 16 + swz / 64; C = (st & 1) * 32 + (swz % 64) / 2; }
__host__ __device__ __forceinline__ int perm32(int rho) { const int n = rho >> 4, i = rho & 15; return 8 * (i >> 2) + 4 * n + (i & 3); }

struct Unit { int pm, pn, ko, g; };
struct Gemm { const bf16_t* A; const bf16_t* Bt; int M, N, K, ld; };

struct StaticOrder {
    int nM, nN, nwg, G, c;
    __host__ __device__ void init(int M, int N, int G_, int c_) { nM = M / BM; nN = N / BM; nwg = nM * nN; G = G_; c = c_; }
    __host__ __device__ bool next(int i, Unit& u) const {
        const long L = (long)i * G + c; if (L >= nwg) return false;
        int wgid = (int)L; { const int q = nwg / NXCD, r = nwg % NXCD, xcd = wgid % NXCD, off = wgid / NXCD; wgid = (xcd < r ? xcd * (q + 1) : r * (q + 1) + (xcd - r) * q) + off; }
        const int nig = WGM * nN, gid = wgid / nig, fm = gid * WGM, gsz = (nM - fm) < WGM ? (nM - fm) : WGM;
        u.pm = fm + ((wgid % nig) % gsz); u.pn = (wgid % nig) / gsz; u.ko = 0; u.g = 0; return true;
    }
    __device__ __forceinline__ void a_ready(const Unit&) const {}
    __device__ __forceinline__ void done(const Unit&) const {}
};

__device__ __forceinline__ unsigned cvt_pk_bf16(float lo, float hi) { unsigned r; asm volatile("v_cvt_pk_bf16_f32 %0, %1, %2" : "=v"(r) : "v"(lo), "v"(hi)); return r; }

struct EpiBf16 {
    static constexpr bool GROUPS = false; static constexpr bool PERM = true, AFTER_DRAIN = false;
    bf16_t* O; int ldc;
    __device__ __forceinline__ void operator()(const f32x4 (&acc)[2][2][4][2], const Unit& u, int wr, int wc, int fr, int fq) const {
        const int row0 = u.pm * BM + wr * 64 + fr; const int col0 = u.pn * BM + wc * 32 + 8 * fq;
#pragma unroll
        for (int ai = 0; ai < 2; ++ai)
#pragma unroll
            for (int m = 0; m < 4; ++m) { bf16_t* rowp = O + (size_t)(row0 + ai * HALF + m * 16) * ldc + col0;
#pragma unroll
                for (int bj = 0; bj < 2; ++bj) { const f32x4 v0 = acc[ai][bj][m][0], v1 = acc[ai][bj][m][1];
                    u32x4 w; w.x = cvt_pk_bf16(v0[0], v0[1]); w.y = cvt_pk_bf16(v0[2], v0[3]); w.z = cvt_pk_bf16(v1[0], v1[1]); w.w = cvt_pk_bf16(v1[2], v1[3]);
                    *(u32x4*)(rowp + bj * HALF) = w; } }
    }
};
struct EpiF32 {
    static constexpr bool GROUPS = false; static constexpr bool PERM = false, AFTER_DRAIN = false;
    float* C; int ldc;
    __device__ __forceinline__ void operator()(const f32x4 (&acc)[2][2][4][2], const Unit& u, int wr, int wc, int fr, int fq) const {
        const int row0 = u.pm * BM + wr * 64 + fr, col0 = u.pn * BM + wc * 32 + 4 * fq;
#pragma unroll
        for (int ai = 0; ai < 2; ++ai)
#pragma unroll
            for (int m = 0; m < 4; ++m) { float* rowp = C + (size_t)(row0 + ai * HALF + m * 16) * ldc + col0;
#pragma unroll
                for (int bj = 0; bj < 2; ++bj)
#pragma unroll
                    for (int n = 0; n < 2; ++n) *(f32x4*)(rowp + bj * HALF + n * 16) = acc[ai][bj][m][n]; }
    }
};
struct EpiRes {
    static constexpr bool GROUPS = false; static constexpr bool PERM = false, AFTER_DRAIN = false;
    const float* res; float* out; int ldc; float alpha;
    __device__ __forceinline__ void operator()(const f32x4 (&acc)[2][2][4][2], const Unit& u, int wr, int wc, int fr, int fq) const {
        const int row0 = u.pm * BM + wr * 64 + fr, col0 = u.pn * BM + wc * 32 + 4 * fq;
#pragma unroll
        for (int ai = 0; ai < 2; ++ai)
#pragma unroll
            for (int m = 0; m < 4; ++m) { const size_t off = (size_t)(row0 + ai * HALF + m * 16) * ldc + col0;
#pragma unroll
                for (int bj = 0; bj < 2; ++bj)
#pragma unroll
                    for (int n = 0; n < 2; ++n) { const f32x4 r = *(const f32x4*)(res + off + bj * HALF + n * 16); *(f32x4*)(out + off + bj * HALF + n * 16) = r * alpha + acc[ai][bj][m][n]; }
                asm volatile("" ::: "memory"); }
    }
};

__device__ __forceinline__ int* epi_dtacc(int j);
__device__ __forceinline__ const float* epi_rat();
struct Group8Order {
    StaticOrder base; int kq;
    __host__ __device__ void init(int M, int N, int G_, int c_, int Kg_elems) { base.init(M, N, G_, c_); kq = Kg_elems * 2; }
    __host__ __device__ bool next(int i, Unit& u) const { if (!base.next(i >> 3, u)) return false; u.g = i & 7; u.ko = (i & 7) * kq; return true; }
    __device__ __forceinline__ void a_ready(const Unit&) const {}
    __device__ __forceinline__ void done(const Unit&) const {}
};
struct SplitK4Order {
    int G, c, nunits, kq;
    __host__ __device__ void init(int M, int Kq_elems, int G_, int c_) { G = G_; c = c_; nunits = (M / BM) * 4; kq = Kq_elems * 2; }
    __host__ __device__ bool next(int i, Unit& u) const { const long L = (long)i * G + c; if (L >= nunits) return false; u.pm = (int)(L >> 2); u.pn = 0; u.ko = (int)(L & 3) * kq; u.g = 0; return true; }
    __device__ __forceinline__ void a_ready(const Unit&) const {}
    __device__ __forceinline__ void done(const Unit&) const {}
};
struct EpiDt {
    static constexpr bool GROUPS = false; static constexpr bool PERM = false, AFTER_DRAIN = false;
    int j;
    __device__ __forceinline__ void operator()(const f32x4 (&acc)[2][2][4][2], const Unit& u, int wr, int wc, int fr, int fq) const {
        int* dacc = epi_dtacc(j);
        const int row0 = u.pm * BM + wr * 64 + fr, col0 = wc * 32 + 4 * fq;
#pragma unroll
        for (int ai = 0; ai < 2; ++ai)
#pragma unroll
            for (int m = 0; m < 4; ++m) { int* rowp = dacc + (size_t)(row0 + ai * HALF + m * 16) * 128 + col0;
#pragma unroll
                for (int n = 0; n < 2; ++n)
#pragma unroll
                    for (int e = 0; e < 4; ++e) atomicAdd(rowp + n * 16 + e, __float2int_rn(acc[ai][0][m][n][e] * 1048576.f)); }
    }
};
struct EpiPtrs { const bf16_t* resb; float* out; bf16_t* ybf; float* s1; float* s2; float* q32; const float* c1; const float* c2; };
__device__ __forceinline__ EpiPtrs epi_ptrs(int layer);
template <bool GRP> struct EpiResS {
    static constexpr bool PERM = true, AFTER_DRAIN = false, GROUPS = GRP;
    int layer; int ldc; float alpha;
    __device__ __forceinline__ void regroup(f32x4 (&acc)[2][2][4][2], const Unit& u, int g, int wr) const {
        const float* rat = epi_rat();
        int ln = threadIdx.x & 63; asm volatile("" : "+v"(ln)); const int fr = ln & 15;
        const float* rp = rat + (size_t)(u.pm * BM + wr * 64 + fr) * 8 + g;
#pragma unroll
        for (int ai = 0; ai < 2; ++ai)
#pragma unroll
            for (int m = 0; m < 4; ++m) { const float ratio = rp[(ai * HALF + m * 16) * 8];
#pragma unroll
                for (int bj = 0; bj < 2; ++bj)
#pragma unroll
                    for (int n = 0; n < 2; ++n) acc[ai][bj][m][n] = acc[ai][bj][m][n] * ratio; }
    }
    __device__ __forceinline__ void operator()(const f32x4 (&acc)[2][2][4][2], const Unit& u, int wr, int wc, int fr_, int fq_) const {
        const EpiPtrs P = epi_ptrs(layer);
        const bf16_t* res = P.resb; bf16_t* ybf = P.ybf; float* s1 = P.s1; float* s2 = P.s2;
        int ln = threadIdx.x & 63; asm volatile("" : "+v"(ln));
        const int fr = ln & 15, fq = ln >> 4; (void)fr_; (void)fq_;
        const int x16 = (ln ^ 16) << 2, x32 = (ln ^ 32) << 2;
        const int row0 = u.pm * BM + wr * 64 + fr, col0 = u.pn * BM + wc * 32 + 8 * fq;
#pragma unroll
        for (int ai = 0; ai < 2; ++ai)
#pragma unroll
            for (int m = 0; m < 4; ++m) { const int row = row0 + ai * HALF + m * 16; const size_t off = (size_t)row * ldc + col0; float a1 = 0.f, a2 = 0.f;
                float gsc = 1.0f; if constexpr (GRP) gsc = epi_rat()[(size_t)row * 8];
#pragma unroll
                for (int bj = 0; bj < 2; ++bj) { const u32x4 rb = __builtin_nontemporal_load((const u32x4*)(res + off + bj * HALF));
                    const f32x4 r0 = (f32x4){__uint_as_float(rb.x << 16), __uint_as_float(rb.x & 0xffff0000u), __uint_as_float(rb.y << 16), __uint_as_float(rb.y & 0xffff0000u)}, r1 = (f32x4){__uint_as_float(rb.z << 16), __uint_as_float(rb.z & 0xffff0000u), __uint_as_float(rb.w << 16), __uint_as_float(rb.w & 0xffff0000u)};
                    const f32x4 y0 = r0 * alpha + acc[ai][bj][m][0] * gsc, y1 = r1 * alpha + acc[ai][bj][m][1] * gsc;
                    u32x4 w; w.x = cvt_pk_bf16(y0[0], y0[1]); w.y = cvt_pk_bf16(y0[2], y0[3]); w.z = cvt_pk_bf16(y1[0], y1[1]); w.w = cvt_pk_bf16(y1[2], y1[3]); *(u32x4*)(ybf + off + bj * HALF) = w;
                    a1 += ((y0[0] + y0[1]) + (y0[2] + y0[3])) + ((y1[0] + y1[1]) + (y1[2] + y1[3]));
                    a2 += ((y0[0] * y0[0] + y0[1] * y0[1]) + (y0[2] * y0[2] + y0[3] * y0[3])) + ((y1[0] * y1[0] + y1[1] * y1[1]) + (y1[2] * y1[2] + y1[3] * y1[3])); }
                a1 += __builtin_bit_cast(float, __builtin_amdgcn_ds_bpermute(x16, __builtin_bit_cast(int, a1))); a2 += __builtin_bit_cast(float, __builtin_amdgcn_ds_bpermute(x16, __builtin_bit_cast(int, a2)));
                a1 += __builtin_bit_cast(float, __builtin_amdgcn_ds_bpermute(x32, __builtin_bit_cast(int, a1))); a2 += __builtin_bit_cast(float, __builtin_amdgcn_ds_bpermute(x32, __builtin_bit_cast(int, a2)));
                if (fq == 0) { atomicAdd((int*)s1 + row, __float2int_rn(a1 * 65536.f)); atomicAdd((int*)s2 + row, __float2int_rn(a2 * 4096.f)); }
                asm volatile("" ::: "memory"); }
    }
};
struct EpiQ {
    static constexpr bool GROUPS = false; static constexpr bool PERM = false, AFTER_DRAIN = false;
    int layer; int ldc; float inv_d, eps;
    __device__ __forceinline__ void operator()(const f32x4 (&acc)[2][2][4][2], const Unit& u, int wr, int wc, int fr, int fq) const {
        const EpiPtrs P = epi_ptrs(layer);
        float* C = P.q32; const float* s1 = P.s1; const float* s2 = P.s2; const float* c1 = P.c1; const float* c2 = P.c2;
        const int row0 = u.pm * BM + wr * 64 + fr, col0 = u.pn * BM + wc * 32 + 4 * fq;
        f32x4 k1[2][2], k2[2][2];
#pragma unroll
        for (int bj = 0; bj < 2; ++bj)
#pragma unroll
            for (int n = 0; n < 2; ++n) { typedef int i32x4 __attribute__((ext_vector_type(4))); const i32x4 i1 = *(const i32x4*)((const int*)c1 + col0 + bj * HALF + n * 16), i2 = *(const i32x4*)((const int*)c2 + col0 + bj * HALF + n * 16);
                k1[bj][n] = (f32x4){(float)i1[0], (float)i1[1], (float)i1[2], (float)i1[3]} * (1.0f / 16777216.f); k2[bj][n] = (f32x4){(float)i2[0], (float)i2[1], (float)i2[2], (float)i2[3]} * (1.0f / 16777216.f); }
#pragma unroll
        for (int ai = 0; ai < 2; ++ai)
#pragma unroll
            for (int m = 0; m < 4; ++m) { const int row = row0 + ai * HALF + m * 16; float* rowp = C + (size_t)row * ldc + col0;
                const float mu = (float)((const int*)s1)[row] * (inv_d * (1.0f / 65536.f)); const float var = fmaxf((float)((const int*)s2)[row] * (inv_d * (1.0f / 4096.f)) - mu * mu, 0.f); const float rs = 1.0f / sqrtf(var + eps); const float rm = rs * mu;
#pragma unroll
                for (int bj = 0; bj < 2; ++bj)
#pragma unroll
                    for (int n = 0; n < 2; ++n) *(f32x4*)(rowp + bj * HALF + n * 16) = acc[ai][bj][m][n] * rs - k1[bj][n] * rm + k2[bj][n]; }
    }
};

template <class Epi, class Sched, bool ALIGN_EPI = false, bool SP2 = false>
__device__ __forceinline__ void gemm_phase(PG8_LAS unsigned char* lds, const Gemm g, const Sched& S, const Epi& E) {
    int tid_ = threadIdx.x; asm volatile("" : "+v"(tid_));
    const int tid = tid_, wid = __builtin_amdgcn_readfirstlane(tid >> 6), lane = tid & 63, wr = wid >> 2, wc = wid & 3, fr = lane & 15, fq = lane >> 4;
    const int K = g.K, nt = K / BK;
    unsigned voffA[2], voffB[2];
#pragma unroll
    for (int i = 0; i < 2; ++i) { int R, C; stage_rc(tid * 16 + i * 8192, R, C); const int Rb = Epi::PERM ? ((R & ~31) + perm32(R & 31)) : R;
        voffA[i] = (unsigned)(R * g.ld + C) * 2u; voffB[i] = (unsigned)(Rb * g.ld + C) * 2u; }
    const size_t kstep = (size_t)(BK * 2);
    const size_t hstep = (size_t)HALF * g.ld * 2;
    const size_t tstep = 2 * hstep;
    const unsigned ldsw = (unsigned)wid * 1024u;
    const int aoff = lds_byte(wr * 64 + fr, fq * 8), boff = lds_byte(wc * 32 + fr, fq * 8);
#define PG8_SA(b, h) (((b) * 2 + (h)) * HTB)
#define PG8_SB(b, h) ((4 + (b) * 2 + (h)) * HTB)
#define PG8_STAGE(bufoff, gbase, voff) do { _Pragma("unroll") for (int _i = 0; _i < 2; ++_i) \
        __builtin_amdgcn_global_load_lds((const unsigned*)((const char*)(gbase) + (voff)[_i]), (PG8_LAS unsigned*)(lds + (bufoff) + ldsw + _i * 8192), 16, 0, 0); } while (0)
#define PG8_LDA(dst, b, h) do { _Pragma("unroll") for (int m = 0; m < 4; ++m) _Pragma("unroll") for (int k = 0; k < 2; ++k) dst[m][k] = *(const PG8_LAS bf16x8*)(lds + PG8_SA(b, h) + aoff + m * 2048 + k * 1024); } while (0)
#define PG8_LDB(dst, b, h) do { _Pragma("unroll") for (int n = 0; n < 2; ++n) _Pragma("unroll") for (int k = 0; k < 2; ++k) dst[n][k] = *(const PG8_LAS bf16x8*)(lds + PG8_SB(b, h) + boff + n * 2048 + k * 1024); } while (0)
#define PG8_MMA(ai, bj, At, Bt) do { __builtin_amdgcn_s_setprio(1); _Pragma("unroll") for (int m = 0; m < 4; ++m) _Pragma("unroll") for (int n = 0; n < 2; ++n) _Pragma("unroll") for (int k = 0; k < 2; ++k) \
        acc[ai][bj][m][n] = __builtin_amdgcn_mfma_f32_16x16x32_bf16(Bt[n][k], At[m][k], acc[ai][bj][m][n], 0, 0, 0); __builtin_amdgcn_s_setprio(0); } while (0)
#define PG8_WAIT_V(n) asm volatile("s_waitcnt vmcnt(" #n ")" ::: "memory")
#define PG8_WAIT_L(n) asm volatile("s_waitcnt lgkmcnt(" #n ")" ::: "memory")
#define PG8_BAR __builtin_amdgcn_s_barrier()
#define PG8_SCHED __builtin_amdgcn_sched_barrier(0)
    Unit cur, nxt; int ui = 0;
    if (!S.next(0, cur)) return;
    f32x4 acc[2][2][4][2];
#pragma unroll
    for (int a = 0; a < 2; ++a)
#pragma unroll
        for (int b = 0; b < 2; ++b)
#pragma unroll
            for (int m = 0; m < 4; ++m)
#pragma unroll
                for (int n = 0; n < 2; ++n) acc[a][b][m][n] = (f32x4){0.f, 0.f, 0.f, 0.f};
    bf16x8 At[4][2], B0[2][2], B1[2][2];
    const char* cA = (const char*)g.A + (size_t)cur.pm * tstep + cur.ko; const char* cB = (const char*)g.Bt + (size_t)cur.pn * tstep + cur.ko;
    S.a_ready(cur);
    if constexpr (SP2) {
        PG8_STAGE(PG8_SB(0, 0), cB, voffB); PG8_STAGE(PG8_SB(0, 1), cB + hstep, voffB); PG8_STAGE(PG8_SA(0, 0), cA, voffA); PG8_STAGE(PG8_SA(0, 1), cA + hstep, voffA);
        if (wr == 1) PG8_BAR;
        PG8_WAIT_V(2); PG8_BAR;
        PG8_STAGE(PG8_SB(1, 0), cB + kstep, voffB); PG8_STAGE(PG8_SA(1, 0), cA + kstep, voffA); PG8_STAGE(PG8_SB(1, 1), cB + hstep + kstep, voffB);
        PG8_WAIT_V(6); PG8_BAR;
    } else {
        PG8_STAGE(PG8_SB(0, 0), cB, voffB); PG8_STAGE(PG8_SA(0, 0), cA, voffA); PG8_STAGE(PG8_SB(0, 1), cB + hstep, voffB); PG8_STAGE(PG8_SA(0, 1), cA + hstep, voffA);
        if (wr == 1) PG8_BAR;
        PG8_WAIT_V(4); PG8_BAR;
        PG8_STAGE(PG8_SB(1, 0), cB + kstep, voffB); PG8_STAGE(PG8_SA(1, 0), cA + kstep, voffA); PG8_STAGE(PG8_SB(1, 1), cB + hstep + kstep, voffB);
        PG8_WAIT_V(6); PG8_BAR;
    }
    for (;;) {
        const bool has_next = S.next(ui + 1, nxt);
        const char* nA = has_next ? (const char*)g.A + (size_t)nxt.pm * tstep + nxt.ko : cA; const char* nB = has_next ? (const char*)g.Bt + (size_t)nxt.pn * tstep + nxt.ko : cB;
        for (int t = 0; t < nt; t += 2) {
            const bool last = (t == nt - 2);
            const char* a1 = cA + (size_t)(t + 1) * kstep;
            const char* a2 = last ? nA : cA + (size_t)(t + 2) * kstep; const char* b2 = last ? nB : cB + (size_t)(t + 2) * kstep;
            const char* a3 = a2 + kstep; const char* b3 = b2 + kstep;
            if (last && has_next) S.a_ready(nxt);
            if constexpr (SP2) {
            PG8_LDB(B0, 0, 0); PG8_LDB(B1, 0, 1); PG8_SCHED; PG8_LDA(At, 0, 0); PG8_STAGE(PG8_SA(1, 1), a1 + hstep, voffA);
            PG8_WAIT_V(8); PG8_WAIT_L(0); PG8_BAR; PG8_MMA(0, 0, At, B0); PG8_MMA(0, 1, At, B1); PG8_BAR; PG8_SCHED;
            PG8_LDA(At, 0, 1); PG8_STAGE(PG8_SB(0, 0), b2, voffB); PG8_STAGE(PG8_SB(0, 1), b2 + hstep, voffB); PG8_STAGE(PG8_SA(0, 0), a2, voffA);
            PG8_WAIT_V(8); PG8_WAIT_L(0); PG8_BAR; PG8_MMA(1, 0, At, B0); PG8_MMA(1, 1, At, B1); PG8_BAR; PG8_SCHED;
            PG8_LDB(B0, 1, 0); PG8_LDB(B1, 1, 1); PG8_SCHED; PG8_LDA(At, 1, 0); PG8_STAGE(PG8_SA(0, 1), a2 + hstep, voffA);
            PG8_WAIT_V(8); PG8_WAIT_L(0); PG8_BAR; PG8_MMA(0, 0, At, B0); PG8_MMA(0, 1, At, B1); PG8_BAR; PG8_SCHED;
            PG8_LDA(At, 1, 1); PG8_STAGE(PG8_SB(1, 0), b3, voffB); PG8_STAGE(PG8_SB(1, 1), b3 + hstep, voffB); PG8_STAGE(PG8_SA(1, 0), a3, voffA);
            PG8_WAIT_V(8); PG8_WAIT_L(0); PG8_BAR; PG8_MMA(1, 0, At, B0); PG8_MMA(1, 1, At, B1); PG8_BAR; PG8_SCHED;
            } else {
            PG8_LDB(B0, 0, 0); PG8_SCHED; PG8_LDA(At, 0, 0); PG8_STAGE(PG8_SA(1, 1), a1 + hstep, voffA);
            PG8_WAIT_L(8); PG8_BAR; PG8_WAIT_L(0); PG8_MMA(0, 0, At, B0); PG8_BAR; PG8_SCHED;
            PG8_LDB(B1, 0, 1); PG8_STAGE(PG8_SB(0, 0), b2, voffB);
            PG8_BAR; PG8_WAIT_L(0); PG8_MMA(0, 1, At, B1); PG8_BAR;
            PG8_LDA(At, 0, 1); PG8_STAGE(PG8_SA(0, 0), a2, voffA);
            PG8_BAR; PG8_WAIT_L(0); PG8_MMA(1, 0, At, B0); PG8_BAR; PG8_SCHED;
            PG8_STAGE(PG8_SB(0, 1), b2 + hstep, voffB);
            PG8_WAIT_V(6); PG8_BAR; PG8_MMA(1, 1, At, B1); PG8_BAR;
            PG8_LDB(B0, 1, 0); PG8_SCHED; PG8_LDA(At, 1, 0); PG8_STAGE(PG8_SA(0, 1), a2 + hstep, voffA);
            PG8_WAIT_L(8); PG8_BAR; PG8_WAIT_L(0); PG8_MMA(0, 0, At, B0); PG8_BAR; PG8_SCHED;
            PG8_LDB(B1, 1, 1); PG8_STAGE(PG8_SB(1, 0), b3, voffB);
            PG8_BAR; PG8_WAIT_L(0); PG8_MMA(0, 1, At, B1); PG8_BAR;
            PG8_LDA(At, 1, 1); PG8_STAGE(PG8_SA(1, 0), a3, voffA);
            PG8_BAR; PG8_WAIT_L(0); PG8_MMA(1, 0, At, B0); PG8_BAR; PG8_SCHED;
            PG8_STAGE(PG8_SB(1, 1), b3 + hstep, voffB);
            PG8_WAIT_V(6); PG8_BAR; PG8_MMA(1, 1, At, B1); PG8_BAR;
            }
        }
        if constexpr (ALIGN_EPI) { if (wr == 0) PG8_BAR; }
        if constexpr (!Epi::AFTER_DRAIN) { if constexpr (Epi::GROUPS) { if (cur.g < 7) E.regroup(acc, cur, cur.g + 1, wr); else E(acc, cur, wr, wc, fr, fq); } else E(acc, cur, wr, wc, fr, fq); S.done(cur); }
        if (!has_next) break;
        if (!Epi::GROUPS || nxt.g == 0) {
#pragma unroll
        for (int a = 0; a < 2; ++a)
#pragma unroll
            for (int b = 0; b < 2; ++b)
#pragma unroll
                for (int m = 0; m < 4; ++m)
#pragma unroll
                    for (int n = 0; n < 2; ++n) acc[a][b][m][n] = (f32x4){0.f, 0.f, 0.f, 0.f};
        }
        cur = nxt; cA = nA; cB = nB; ++ui;
        if constexpr (ALIGN_EPI) { if (wr == 1) PG8_BAR; }
    }
    PG8_WAIT_V(0);
    if constexpr (!ALIGN_EPI) { if (wr == 0) PG8_BAR; }
    PG8_BAR;
#undef PG8_SA
#undef PG8_SB
#undef PG8_STAGE
#undef PG8_LDA
#undef PG8_LDB
#undef PG8_MMA
#undef PG8_WAIT_V
#undef PG8_WAIT_L
#undef PG8_BAR
#undef PG8_SCHED
}
}

constexpr int NWAVES = 8, NTHREADS = 512;
constexpr int D = 4096, BATCH = 4, SEQ = 4096, T = BATCH * SEQ, DEPTH = 4;
constexpr int DI = 8192, HD = 64, NH = 128, NG = 8, NST = 128, CONVD = DI + 2 * NG * NST  , PROJ = DI + CONVD + NH  , PROJP = 18688  , PROJM = 18432  ;
constexpr int PH = 8, NK = 128, PK = 16, HALFD = 128, QD = PH * 2 * HALFD  , NEXP = NK * NK;
constexpr float LN_EPS = 1e-5f, RMS_EPS = 1e-5f;
constexpr float ALPHA = 1.681792830507429f;

constexpr size_t MiB = 1u << 20;
constexpr size_t WS_CTL = 0, CTL_ZERO_BYTES = 1 * MiB;
constexpr size_t SZ_W_SSD_IN = (size_t)PROJP * D * 2, SZ_W_SSD_OUT = (size_t)D * DI * 2, SZ_W_SC_IN = (size_t)3 * D * D * 2, SZ_W_SC_OUT = (size_t)D * D * 2, SZ_W_WQ = (size_t)QD * D * 2, SZ_W_UV = (size_t)NEXP * D * 2;
constexpr size_t WS_W_SSD_IN = 1 * MiB;
constexpr size_t WS_W_SSD_OUT = WS_W_SSD_IN + 2 * SZ_W_SSD_IN;
constexpr size_t WS_W_SC_IN = WS_W_SSD_OUT + 2 * SZ_W_SSD_OUT;
constexpr size_t WS_W_SC_OUT = WS_W_SC_IN + 2 * SZ_W_SC_IN;
constexpr size_t WS_W_WQ = WS_W_SC_OUT + 2 * SZ_W_SC_OUT;
constexpr size_t WS_W_U = WS_W_WQ + 4 * SZ_W_WQ;
constexpr size_t WS_W_V = WS_W_U + 4 * SZ_W_UV;
constexpr size_t WS_X32 = WS_W_V + 4 * SZ_W_UV;
constexpr size_t WS_XB = WS_X32 + (size_t)T * D * 4;
constexpr size_t WS_ZX = WS_XB + (size_t)T * D * 2;
constexpr size_t WS_XBC = WS_ZX + (size_t)T * PROJP * 2;
constexpr size_t WS_YB = WS_XBC + (size_t)T * CONVD * 2;
constexpr size_t WS_Q32 = WS_YB + (size_t)T * DI * 2;
constexpr size_t WS_DT = WS_Q32 + (size_t)T * QD * 4;
constexpr size_t WS_DA = WS_DT + (size_t)T * NH * 4;
constexpr size_t WS_EIDX = WS_DA + (size_t)T * NH * 4;
constexpr size_t WS_GATES = WS_EIDX + (size_t)T * 128 * 4;
constexpr size_t WS_RS = WS_GATES + (size_t)T * 128 * 4;
constexpr size_t WS_YBF = WS_RS + (size_t)2 * 4 * NEXP * 4;
constexpr size_t WS_DTACC = WS_YBF + (size_t)T * D * 2;
constexpr size_t WS_SS = WS_DTACC + (size_t)2 * T * NH * 4;
constexpr size_t WS_RAT = WS_SS + (size_t)2 * T * NG * 8;
constexpr size_t WS_END = WS_RAT + (size_t)T * NG * 4;
static_assert(WS_END <= (size_t)4096 * MiB, "workspace map exceeds 4 GiB");
constexpr int CW_BAR = 4096;
constexpr int CW_C = 16384;
constexpr int CW_ST = 65536;
static_assert((size_t)(CW_ST + 4 * 2 * 16384) * 4 <= 1u << 20, "CTL words inside the memset region");

constexpr int RING_BYTES = 131072;
constexpr int LDSCTL_OFF = RING_BYTES, MISC_OFF = LDSCTL_OFF + 320;
constexpr int LDS_BYTES = 147456;

#define GAS __attribute__((address_space(1)))
#define LAS __attribute__((address_space(3)))
typedef unsigned short bf16;
typedef unsigned v4u __attribute__((ext_vector_type(4)));
typedef float f32x4 __attribute__((ext_vector_type(4)));
typedef float f32x2 __attribute__((ext_vector_type(2)));
typedef __bf16 bf16x2_t __attribute__((ext_vector_type(2)));

__device__ __forceinline__ float bf_lo(unsigned w) { return __uint_as_float(w << 16); }
__device__ __forceinline__ float bf_hi(unsigned w) { return __uint_as_float(w & 0xffff0000u); }
__device__ __forceinline__ unsigned pk2(float lo, float hi) { return pg8::cvt_pk_bf16(lo, hi); }
#define DPP_ADD_STEP(v, ctrl, rmask) do { const int t_ = __builtin_amdgcn_update_dpp(0, __builtin_bit_cast(int, v), (ctrl), (rmask), 0xf, false); v += __builtin_bit_cast(float, t_); } while (0)
__device__ __forceinline__ float wave_sum(float v) {
    DPP_ADD_STEP(v, 0xB1, 0xf); DPP_ADD_STEP(v, 0x4E, 0xf); DPP_ADD_STEP(v, 0x141, 0xf); DPP_ADD_STEP(v, 0x140, 0xf);
    DPP_ADD_STEP(v, 0x142, 0xa); DPP_ADD_STEP(v, 0x143, 0xc);
    return __builtin_bit_cast(float, __builtin_amdgcn_readlane(__builtin_bit_cast(int, v), 63));
}
__device__ __forceinline__ float wave_max(float v) {
#pragma unroll
    for (int o = 1; o < 64; o <<= 1) v = fmaxf(v, __shfl_xor(v, o));
    return v;
}
__device__ __forceinline__ float dot2bf(unsigned a, unsigned b, float acc) { return __builtin_amdgcn_fdot2_f32_bf16(__builtin_bit_cast(bf16x2_t, a), __builtin_bit_cast(bf16x2_t, b), acc, false); }
__device__ __forceinline__ float dot8(const v4u a, const v4u b, float s) { s = dot2bf(a.x, b.x, s); s = dot2bf(a.y, b.y, s); s = dot2bf(a.z, b.z, s); s = dot2bf(a.w, b.w, s); return s; }
#define DPP_MAX_STEP(v, ctrl, rmask) do { const int t_ = __builtin_amdgcn_update_dpp(__builtin_bit_cast(int, v), __builtin_bit_cast(int, v), (ctrl), (rmask), 0xf, false); v = fmaxf(v, __builtin_bit_cast(float, t_)); } while (0)
__device__ __forceinline__ float wave_max_u(float v) {
    DPP_MAX_STEP(v, 0xB1, 0xf);
    DPP_MAX_STEP(v, 0x4E, 0xf);
    DPP_MAX_STEP(v, 0x141, 0xf);
    DPP_MAX_STEP(v, 0x140, 0xf);
    DPP_MAX_STEP(v, 0x142, 0xa);
    DPP_MAX_STEP(v, 0x143, 0xc);
    return __builtin_bit_cast(float, __builtin_amdgcn_readlane(__builtin_bit_cast(int, v), 63));
}
__device__ __forceinline__ float silu_f(float x) { return x * __builtin_amdgcn_rcpf(1.f + __expf(-x)); }

#define XB_TMO      128
#define XB_XCNT(j)  (256  + 64 * (j))
#define XB_XSUB(j)  (1280 + 64 * (j))
#define XB_XGEN(j)  (2304 + 64 * (j))
#define XB_TOP      3328
#define XB_TOPGEN   3392
#define XCD_BAR_WORDS 3456
#define XB_SPIN_CAP (1u << 18)
__device__ __forceinline__ unsigned xb_ld(unsigned* p)              { return __hip_atomic_load(p, __ATOMIC_RELAXED, __HIP_MEMORY_SCOPE_AGENT); }
__device__ __forceinline__ unsigned xb_add(unsigned* p, unsigned v) { return __hip_atomic_fetch_add(p, v, __ATOMIC_RELAXED, __HIP_MEMORY_SCOPE_AGENT); }
__device__ __forceinline__ unsigned xb_xcc_id() { return (unsigned)__builtin_amdgcn_s_getreg((3 << 11) | 20) & 0xFu; }
#define XB_SPIN(cond, bar) do { unsigned _sp = 0; while (cond) { __builtin_amdgcn_s_sleep(1); \
    if ((++_sp & 255u) == 0u) { if (xb_ld(&(bar)[XB_TMO])) break; if (_sp > XB_SPIN_CAP) { atomicAdd(&(bar)[XB_TMO], 1u); break; } } } } while (0)
struct XcdBarrier { unsigned* bar; unsigned x; volatile LAS unsigned* st; };
__device__ __forceinline__ XcdBarrier xcd_barrier_post(unsigned* bar, volatile LAS unsigned* st) {
    XcdBarrier b; b.bar = bar; b.x = xb_xcc_id(); b.st = st;
    if (threadIdx.x == 0) (void)xb_add(&bar[XB_XCNT(b.x)], 1u);
    return b;
}
__device__ __forceinline__ void xcd_barrier_complete(unsigned* bar, unsigned x, unsigned& nloc, unsigned& nx) {
    const unsigned G = gridDim.x * gridDim.y * gridDim.z;
    unsigned sum, cnt, mine, sp = 0u;
    for (;;) {
        sum = 0u; cnt = 0u; mine = 0u;
#pragma unroll
        for (unsigned j = 0; j < 16; ++j) { const unsigned c = xb_ld(&bar[XB_XCNT(j)]); sum += c; cnt += (c > 0u) ? 1u : 0u; mine = (j == x) ? c : mine; }
        if (sum == G) break;
        __builtin_amdgcn_s_sleep(1);
        if ((++sp & 255u) == 0u) { if (xb_ld(&bar[XB_TMO])) break; if (sp > XB_SPIN_CAP) { atomicAdd(&bar[XB_TMO], 1u); break; } }
    }
    nloc = mine > 0u ? mine : 1u; nx = cnt > 0u ? cnt : 1u;
}
__device__ __forceinline__ void xcd_barrier(const XcdBarrier& b) {
    asm volatile("s_waitcnt vmcnt(0)" ::: "memory");
    __syncthreads();
    if (threadIdx.x == 0) {
        unsigned* bar = b.bar;
        __builtin_amdgcn_s_waitcnt(0);
        unsigned nloc = b.st[0], nx = b.st[1];
        if (nloc == 0u) { xcd_barrier_complete(bar, b.x, nloc, nx); b.st[0] = nloc; b.st[1] = nx; }
        const unsigned old = xb_add(&bar[XB_XSUB(b.x)], 1u);
        const unsigned gen = old / nloc;
        if (old + 1u == (gen + 1u) * nloc) {
            __builtin_amdgcn_fence(__ATOMIC_RELEASE, "agent");
            asm volatile("s_waitcnt vmcnt(0)" ::: "memory");
            const unsigned og = xb_add(&bar[XB_TOP], 1u);
            const unsigned tg = og / nx;
            if (og + 1u == (tg + 1u) * nx) xb_add(&bar[XB_TOPGEN], 1u);
            else XB_SPIN(xb_ld(&bar[XB_TOPGEN]) == tg, bar);
            __builtin_amdgcn_fence(__ATOMIC_ACQUIRE, "agent");
            xb_add(&bar[XB_XGEN(b.x)], 1u);
            asm volatile("s_waitcnt vmcnt(0)" ::: "memory");
        } else {
            XB_SPIN(xb_ld(&bar[XB_XGEN(b.x)]) == gen, bar);
            __builtin_amdgcn_fence(__ATOMIC_ACQUIRE, "agent");
            asm volatile("s_waitcnt vmcnt(0)" ::: "memory");
        }
    }
    __syncthreads();
}

struct Args {
    const float* in[20]; float* out; unsigned char* ws; int ph_lo, ph_hi, use_bar, pad;
};
typedef const __attribute__((address_space(4))) Args* KArgs;
#define KA() ({ KArgs p_ = (KArgs)__builtin_amdgcn_kernarg_segment_ptr(); asm volatile("" : "+s"(p_)); p_; })
namespace pg8 {
__device__ __forceinline__ const float* epi_rat() { KArgs ka = KA(); return (const float*)(ka->ws + WS_RAT); }
__device__ __forceinline__ int* epi_dtacc(int j) { KArgs ka = KA(); return (int*)(ka->ws + WS_DTACC) + (size_t)j * T * NH; }
__device__ __forceinline__ EpiPtrs epi_ptrs(int layer) {
    KArgs ka = KA(); unsigned char* w = ka->ws; EpiPtrs P;
    P.resb = (const bf16_t*)(w + WS_XB); P.out = ka->out; P.ybf = (bf16_t*)(w + WS_YBF);
    P.s1 = (float*)(w + WS_CTL) + CW_ST + layer * 2 * T; P.s2 = P.s1 + T; P.q32 = (float*)(w + WS_Q32);
    P.c1 = (const float*)(w + WS_CTL) + CW_C + layer * 4096; P.c2 = P.c1 + 2048; return P;
}
}
struct Frame {
    LAS unsigned char* lds;
    int tid, lane, wave, G, gw, NGW;
};

__device__ __forceinline__ void p0_transpose_item(const float* __restrict__ W, int K, int N, bf16* WT, LAS float* scr, int item, int lane, const float* rsc = nullptr) {
    const int nblk = N / 32, kb = item / nblk, nb = item % nblk, k0 = 64 * kb, n0 = 32 * nb;
    { f32x4 t4[8];
#pragma unroll
      for (int i = 0; i < 8; ++i) t4[i] = __builtin_nontemporal_load((const f32x4*)(W + (size_t)(k0 + 8 * i + (lane >> 3)) * N + n0 + 4 * (lane & 7)));
#pragma unroll
      for (int i = 0; i < 8; ++i) { LAS float* d = scr + (8 * i + (lane >> 3)) * 33 + 4 * (lane & 7); d[0] = t4[i][0]; d[1] = t4[i][1]; d[2] = t4[i][2]; d[3] = t4[i][3]; } }
    asm volatile("s_waitcnt lgkmcnt(0)" ::: "memory");
    const int c = lane & 7;
    f32x4 ga = (f32x4){1.f, 1.f, 1.f, 1.f}, gb = ga; if (rsc) { ga = *(const f32x4*)(rsc + k0 + 8 * c); gb = *(const f32x4*)(rsc + k0 + 8 * c + 4); }
#pragma unroll
    for (int j = 0; j < 4; ++j) { const int n = (lane >> 3) + 8 * j; const LAS float* s = scr + (8 * c) * 33 + n;
        v4u o; o.x = pk2(ga[0] * s[0 * 33], ga[1] * s[1 * 33]); o.y = pk2(ga[2] * s[2 * 33], ga[3] * s[3 * 33]); o.z = pk2(gb[0] * s[4 * 33], gb[1] * s[5 * 33]); o.w = pk2(gb[2] * s[6 * 33], gb[3] * s[7 * 33]);
        __builtin_nontemporal_store(o, (v4u*)(WT + (size_t)(n0 + n) * K + k0 + 8 * c)); }
    asm volatile("s_waitcnt lgkmcnt(0)" ::: "memory");
}
__device__ __forceinline__ void p0_transpose_item_wq(const float* __restrict__ W, int K, int N, bf16* WT, LAS float* scr, int item, int lane, const float* g1, const float* b1, float* c1, float* c2) {
    const int nblk = N / 32, kb = item / nblk, nb = item % nblk, k0 = 64 * kb, n0 = 32 * nb;
    { f32x4 t4[8];
#pragma unroll
      for (int i = 0; i < 8; ++i) t4[i] = __builtin_nontemporal_load((const f32x4*)(W + (size_t)(k0 + 8 * i + (lane >> 3)) * N + n0 + 4 * (lane & 7)));
#pragma unroll
      for (int i = 0; i < 8; ++i) { LAS float* d = scr + (8 * i + (lane >> 3)) * 33 + 4 * (lane & 7); d[0] = t4[i][0]; d[1] = t4[i][1]; d[2] = t4[i][2]; d[3] = t4[i][3]; } }
    asm volatile("s_waitcnt lgkmcnt(0)" ::: "memory");
    { const int n = lane & 31, hf = lane >> 5; float a1 = 0.f, a2 = 0.f;
      for (int kk = 0; kk < 32; ++kk) { const int k = 32 * hf + kk; const float w = scr[k * 33 + n]; a1 += __uint_as_float(pk2(g1[k0 + k] * w, 0.f) << 16); a2 += b1[k0 + k] * w; }
      a1 += __shfl_xor(a1, 32); a2 += __shfl_xor(a2, 32);
      if (lane < 32) { atomicAdd((int*)c1 + n0 + n, __float2int_rn(a1 * 16777216.f)); atomicAdd((int*)c2 + n0 + n, __float2int_rn(a2 * 16777216.f)); } }
    const int c = lane & 7;
    const f32x4 ga = *(const f32x4*)(g1 + k0 + 8 * c), gb = *(const f32x4*)(g1 + k0 + 8 * c + 4);
#pragma unroll
    for (int j = 0; j < 4; ++j) { const int n = (lane >> 3) + 8 * j; const LAS float* s = scr + (8 * c) * 33 + n;
        v4u o; o.x = pk2(ga[0] * s[0 * 33], ga[1] * s[1 * 33]); o.y = pk2(ga[2] * s[2 * 33], ga[3] * s[3 * 33]); o.z = pk2(gb[0] * s[4 * 33], gb[1] * s[5 * 33]); o.w = pk2(gb[2] * s[6 * 33], gb[3] * s[7 * 33]);
        __builtin_nontemporal_store(o, (v4u*)(WT + (size_t)(n0 + n) * K + k0 + 8 * c)); }
    asm volatile("s_waitcnt lgkmcnt(0)" ::: "memory");
}
__device__ __forceinline__ void cvt_rows(const float* __restrict__ src, bf16* dst, size_t n8, size_t gtid, size_t nthr) {
    for (size_t i = gtid; i < n8; i += nthr) { const f32x4 a = __builtin_nontemporal_load(&((const f32x4*)src)[2 * i]), b = __builtin_nontemporal_load(&((const f32x4*)src)[2 * i + 1]);
        v4u o; o.x = pk2(a[0], a[1]); o.y = pk2(a[2], a[3]); o.z = pk2(b[0], b[1]); o.w = pk2(b[2], b[3]); ((v4u*)dst)[i] = o; }
}
__device__ __forceinline__ void p0_prologue(const Frame& F, KArgs a) {
    unsigned char* ws = a->ws;
    LAS float* scr = (LAS float*)(F.lds + F.wave * 16384);
    constexpr int I_SSD_IN = (D / 64) * (PROJ / 32), I_SSD_OUT = (DI / 64) * (D / 32), I_SC_IN = (D / 64) * (3 * D / 32), I_SC_OUT = (D / 64) * (D / 32), I_WQ = (D / 64) * (QD / 32);
    constexpr int NITEMS = 2 * (I_SSD_IN + I_SSD_OUT + I_SC_IN + I_SC_OUT) + 4 * I_WQ;
    for (int it = F.gw; it < NITEMS; it += F.NGW) {
        int r = it;
        if (r < 2 * I_SSD_IN) { const int j = r / I_SSD_IN; r -= j * I_SSD_IN; p0_transpose_item(a->in[1] + (size_t)j * D * PROJ, D, PROJ, (bf16*)(ws + WS_W_SSD_IN + j * SZ_W_SSD_IN), scr, r, F.lane); continue; } r -= 2 * I_SSD_IN;
        if (r < 2 * I_SSD_OUT) { const int j = r / I_SSD_OUT; r -= j * I_SSD_OUT; p0_transpose_item(a->in[8] + (size_t)j * DI * D, DI, D, (bf16*)(ws + WS_W_SSD_OUT + j * SZ_W_SSD_OUT), scr, r, F.lane, a->in[7] + (size_t)j * DI  ); continue; } r -= 2 * I_SSD_OUT;
        if (r < 2 * I_SC_IN) { const int j = r / I_SC_IN; r -= j * I_SC_IN; p0_transpose_item(a->in[9] + (size_t)j * D * 3 * D, D, 3 * D, (bf16*)(ws + WS_W_SC_IN + j * SZ_W_SC_IN), scr, r, F.lane); continue; } r -= 2 * I_SC_IN;
        if (r < 2 * I_SC_OUT) { const int j = r / I_SC_OUT; r -= j * I_SC_OUT; p0_transpose_item(a->in[11] + (size_t)j * D * D, D, D, (bf16*)(ws + WS_W_SC_OUT + j * SZ_W_SC_OUT), scr, r, F.lane); continue; } r -= 2 * I_SC_OUT;
        { const int j = r / I_WQ; r -= j * I_WQ; float* cc = (float*)(ws + WS_CTL) + CW_C + j * 4096;
          p0_transpose_item_wq(a->in[12] + (size_t)j * D * QD, D, QD, (bf16*)(ws + WS_W_WQ + j * SZ_W_WQ), scr, r, F.lane, a->in[16] + (size_t)j * D, a->in[17] + (size_t)j * D, cc, cc + 2048); }
    }
    const size_t gtid = (size_t)blockIdx.x * NTHREADS + F.tid, nthr = (size_t)F.G * NTHREADS;
    for (int j = 0; j < 2; ++j) { v4u* p = (v4u*)(ws + WS_W_SSD_IN + j * SZ_W_SSD_IN + (size_t)PROJ * D * 2); const size_t n16 = (size_t)(PROJP - PROJ) * D * 2 / 16;
        for (size_t i = gtid; i < n16; i += nthr) p[i] = (v4u){0u, 0u, 0u, 0u}; }
    for (int r = F.gw; r < 2 * 4 * NEXP; r += F.NGW) {
        const int tbl = r / (4 * NEXP), rr = r % (4 * NEXP);
        const float* srow = a->in[14 + tbl] + (size_t)rr * D;
        f32x4 v[16]; float am = 0.f;
#pragma unroll
        for (int i = 0; i < 2; ++i)
#pragma unroll
            for (int k = 0; k < 8; ++k) { v[i * 8 + k] = __builtin_nontemporal_load((const f32x4*)(srow + i * 2048 + k * 256 + F.lane * 4));
                am = fmaxf(am, fmaxf(fmaxf(fabsf(v[i * 8 + k][0]), fabsf(v[i * 8 + k][1])), fmaxf(fabsf(v[i * 8 + k][2]), fabsf(v[i * 8 + k][3])))); }
        am = fmaxf(wave_max(am), 1e-30f);
        const float sc = 6.0f / am;
        unsigned char* drow = ws + WS_W_U + (size_t)rr * D + (size_t)tbl * (D / 2);
#pragma unroll
        for (int i = 0; i < 2; ++i) { v4u o;
#pragma unroll
            for (int k = 0; k < 4; ++k) { const f32x4 q0 = v[i * 8 + 2 * k] * sc, q1 = v[i * 8 + 2 * k + 1] * sc; unsigned w = 0u;
                w = __builtin_amdgcn_cvt_scalef32_pk_fp4_f32(w, q0[0], q0[1], 1.0f, 0); w = __builtin_amdgcn_cvt_scalef32_pk_fp4_f32(w, q0[2], q0[3], 1.0f, 1);
                w = __builtin_amdgcn_cvt_scalef32_pk_fp4_f32(w, q1[0], q1[1], 1.0f, 2); w = __builtin_amdgcn_cvt_scalef32_pk_fp4_f32(w, q1[2], q1[3], 1.0f, 3); o[k] = w; }
            __builtin_nontemporal_store(o, (v4u*)(drow + (size_t)(i * 64 + F.lane) * 16)); }
        if (F.lane == 0) ((float*)(ws + WS_RS))[r] = am * (1.0f / 6.0f);
    }
    cvt_rows(a->in[0], (bf16*)(ws + WS_XB), (size_t)T * D / 8, gtid, nthr);
}

__device__ __forceinline__ void ssd_conv_phase(const Frame& F, KArgs a, int j) {
    const bf16* ZX = (const bf16*)(a->ws + WS_ZX); bf16* XBC = (bf16*)(a->ws + WS_XBC);
    const float* cw = a->in[2] + (size_t)j * 4 * CONVD; const float* cb = a->in[3] + (size_t)j * CONVD;
    constexpr int NCB = CONVD / 512, NITEMS = (T / 32) * NCB;
    for (int it = F.gw; it < NITEMS; it += F.NGW) {
        const int tb = it / NCB, cbk = it % NCB, c0 = cbk * 512 + F.lane * 8, t0 = tb * 32;
        float w[4][8], bias[8];
#pragma unroll
        for (int k = 0; k < 4; ++k) { const f32x4 u0 = *(const f32x4*)(cw + (size_t)k * CONVD + c0), u1 = *(const f32x4*)(cw + (size_t)k * CONVD + c0 + 4);
#pragma unroll
            for (int e = 0; e < 4; ++e) { w[k][e] = u0[e]; w[k][4 + e] = u1[e]; } }
        { const f32x4 u0 = *(const f32x4*)(cb + c0), u1 = *(const f32x4*)(cb + c0 + 4);
#pragma unroll
          for (int e = 0; e < 4; ++e) { bias[e] = u0[e]; bias[4 + e] = u1[e]; } }
        float r0[8], r1[8], r2[8];
        const bool head = (t0 % SEQ) == 0;
#pragma unroll
        for (int h = 0; h < 3; ++h) {
            v4u v = (v4u){0u, 0u, 0u, 0u};
            if (!head) v = *(const v4u*)(ZX + (size_t)(t0 - 3 + h) * PROJP + DI + c0);
            float* dst = h == 0 ? r0 : (h == 1 ? r1 : r2);
#pragma unroll
            for (int e = 0; e < 4; ++e) { dst[2 * e] = bf_lo(v[e]); dst[2 * e + 1] = bf_hi(v[e]); }
        }
        for (int tt0 = 0; tt0 < 32; tt0 += 8) {
            v4u vv[8];
#pragma unroll
            for (int k = 0; k < 8; ++k) vv[k] = __builtin_nontemporal_load((const v4u*)(ZX + (size_t)(t0 + tt0 + k) * PROJP + DI + c0));
#pragma unroll
            for (int k = 0; k < 8; ++k) {
                const v4u v = vv[k];
                float cur[8], o[8];
#pragma unroll
                for (int e = 0; e < 4; ++e) { cur[2 * e] = bf_lo(v[e]); cur[2 * e + 1] = bf_hi(v[e]); }
#pragma unroll
                for (int e = 0; e < 8; ++e) { const float s = bias[e] + w[0][e] * r0[e] + w[1][e] * r1[e] + w[2][e] * r2[e] + w[3][e] * cur[e]; o[e] = silu_f(s); r0[e] = r1[e]; r1[e] = r2[e]; r2[e] = cur[e]; }
                v4u ov; ov.x = pk2(o[0], o[1]); ov.y = pk2(o[2], o[3]); ov.z = pk2(o[4], o[5]); ov.w = pk2(o[6], o[7]);
                __builtin_nontemporal_store(ov, (v4u*)(XBC + (size_t)(t0 + tt0 + k) * CONVD + c0));
            }
        }
    }
    float* DT = (float*)(a->ws + WS_DT); const int* DTACC = (const int*)(a->ws + WS_DTACC) + (size_t)j * T * NH;
    const float* dtb = a->in[4] + j * NH;
    const size_t gtid = (size_t)blockIdx.x * NTHREADS + F.tid, nthr = (size_t)F.G * NTHREADS;
    for (size_t i = gtid; i < (size_t)T * NH; i += nthr) {
        const int h = (int)(i % NH); const size_t t = i / NH;
        const float raw = (float)DTACC[i] * (1.0f / 1048576.f) + dtb[h];
        const float dt = raw > 20.f ? raw : log1pf(expf(raw));
        DT[i] = dt;
    }
}

__device__ __forceinline__ void ssd_scan_phase(const Frame& F, KArgs a, int j) {
    const bf16* XBC = (const bf16*)(a->ws + WS_XBC); bf16* YB = (bf16*)(a->ws + WS_YB);
    const float* DT = (const float*)(a->ws + WS_DT); const float* DA = (const float*)(a->ws + WS_DA);
    const float* Dsk = a->in[6] + j * NH;
    LAS float* Bs = (LAS float*)(F.lds);
    LAS float* Cs = (LAS float*)(F.lds + 16384);
    LAS float* Xs = (LAS float*)(F.lds + 32768);
    LAS float* DTs = (LAS float*)(F.lds + 49152);
    LAS float* DAs = (LAS float*)(F.lds + 49152 + 256);
    LAS float* YP = (LAS float*)(F.lds + 65536);
    const int hl = F.wave >> 2, nq = F.wave & 3;
    for (int unit = blockIdx.x; unit < BATCH * (NH / 2); unit += F.G) {
        const int b = unit / (NH / 2), hp = unit % (NH / 2), g = hp >> 3, hg0 = 2 * hp;
        float hst[32];
#pragma unroll
        for (int n = 0; n < 32; ++n) hst[n] = 0.f;
        const int ltt = F.tid >> 4, lcol = (F.tid & 15) * 8;
        v4u vb, vc, vx; float pdt = 0.f, pda = 0.f;
#define SCAN_LOAD(blk_) do { const size_t tg_ = (size_t)b * SEQ + (size_t)(blk_) * 32; const bf16* rowp = XBC + (tg_ + ltt) * CONVD; \
            vb = *(const v4u*)(rowp + DI + g * NST + lcol); vc = *(const v4u*)(rowp + DI + NG * NST + g * NST + lcol); vx = *(const v4u*)(rowp + hg0 * HD + lcol); \
            if (F.tid < 64) { const int t2 = F.tid >> 1, hh = F.tid & 1; pdt = DT[(tg_ + t2) * NH + hg0 + hh]; pda = DA[(tg_ + t2) * NH + hg0 + hh]; } } while (0)
        SCAN_LOAD(0);
        for (int blk = 0; blk < SEQ / 32; ++blk) {
            const size_t tg0 = (size_t)b * SEQ + (size_t)blk * 32;
            {
                const int tt = ltt, col = lcol;
#pragma unroll
                for (int e = 0; e < 4; ++e) { Bs[tt * 128 + col + 2 * e] = bf_lo(vb[e]); Bs[tt * 128 + col + 2 * e + 1] = bf_hi(vb[e]);
                    Cs[tt * 128 + col + 2 * e] = bf_lo(vc[e]); Cs[tt * 128 + col + 2 * e + 1] = bf_hi(vc[e]);
                    Xs[tt * 128 + col + 2 * e] = bf_lo(vx[e]); Xs[tt * 128 + col + 2 * e + 1] = bf_hi(vx[e]); }
                if (F.tid < 64) { DTs[F.tid] = pdt; DAs[F.tid] = pda; }
            }
            __syncthreads();
            if (blk + 1 < SEQ / 32) SCAN_LOAD(blk + 1);
            for (int tt = 0; tt < 32; ++tt) {
                const float dtv = DTs[tt * 2 + hl], dav = DAs[tt * 2 + hl], xv = Xs[tt * 128 + hl * 64 + F.lane];
                const float dx = dtv * xv; float y = 0.f;
#pragma unroll
                for (int n4 = 0; n4 < 8; ++n4) {
                    const f32x4 bv = *(const LAS f32x4*)(Bs + tt * 128 + nq * 32 + n4 * 4), cv = *(const LAS f32x4*)(Cs + tt * 128 + nq * 32 + n4 * 4);
#pragma unroll
                    for (int e = 0; e < 4; ++e) { hst[n4 * 4 + e] = dav * hst[n4 * 4 + e] + dx * bv[e]; y += cv[e] * hst[n4 * 4 + e]; }
                }
                YP[(tt * 8 + F.wave) * 64 + F.lane] = y;
            }
            __syncthreads();
#pragma unroll
            for (int k = 0; k < 8; ++k) {
                const int idx = F.tid + 512 * k, tt = idx >> 7, ch = idx & 127, h2 = ch >> 6, p = ch & 63;
                float y = Dsk[hg0 + h2] * Xs[tt * 128 + ch];
#pragma unroll
                for (int q = 0; q < 4; ++q) y += YP[(tt * 8 + h2 * 4 + q) * 64 + p];
                YB[(tg0 + tt) * DI + hg0 * HD + ch] = (bf16)(pk2(y, 0.f) & 0xffffu);
            }
            __syncthreads();
        }
#undef SCAN_LOAD
    }
}

__device__ __forceinline__ unsigned pk2c(float lo, float hi) { const bf16x2_t v = {(__bf16)lo, (__bf16)hi}; return __builtin_bit_cast(unsigned, v); }
typedef short bf16x8 __attribute__((ext_vector_type(8)));
typedef unsigned v2u __attribute__((ext_vector_type(2)));
constexpr int SC_RS = 272;
constexpr int SC_TILE = 64 * SC_RS;
constexpr int SC_STAGE = 3 * SC_TILE;
constexpr int SC_YS = 2 * SC_STAGE;
constexpr int SC_PRIV = SC_YS + SC_TILE;
constexpr int SC_CB = RING_BYTES + 2048;
static_assert(SC_PRIV + 8 * 1024 <= RING_BYTES && SC_CB + 10 * 1024 <= LDS_BYTES, "scan LDS map");
__device__ __forceinline__ v2u lds_tr2(unsigned addr) { v2u r; asm volatile("ds_read_b64_tr_b16 %0, %1\n\ts_waitcnt lgkmcnt(0)" : "=&v"(r) : "v"(addr) : "memory"); return r; }
__device__ __forceinline__ bf16x8 mk8(v2u a, v2u b) { const v4u t = (v4u){a.x, a.y, b.x, b.y}; return __builtin_bit_cast(bf16x8, t); }
__device__ __forceinline__ bf16x8 lds_tr8(unsigned a0, unsigned a1) { v2u r0, r1; asm volatile("ds_read_b64_tr_b16 %0, %2\n\tds_read_b64_tr_b16 %1, %3\n\ts_waitcnt lgkmcnt(0)" : "=&v"(r0), "=&v"(r1) : "v"(a0), "v"(a1) : "memory"); return mk8(r0, r1); }
__device__ __forceinline__ void lds_tr8x4(unsigned base, bf16x8 (&o)[4]) {
    v2u r0, r1, r2, r3, r4, r5, r6, r7;
    asm volatile("ds_read_b64_tr_b16 %0, %8\n\tds_read_b64_tr_b16 %1, %8 offset:1088\n\tds_read_b64_tr_b16 %2, %8 offset:32\n\tds_read_b64_tr_b16 %3, %8 offset:1120\n\t"
                 "ds_read_b64_tr_b16 %4, %8 offset:64\n\tds_read_b64_tr_b16 %5, %8 offset:1152\n\tds_read_b64_tr_b16 %6, %8 offset:96\n\tds_read_b64_tr_b16 %7, %8 offset:1184\n\ts_waitcnt lgkmcnt(0)"
                 : "=&v"(r0), "=&v"(r1), "=&v"(r2), "=&v"(r3), "=&v"(r4), "=&v"(r5), "=&v"(r6), "=&v"(r7) : "v"(base) : "memory");
    o[0] = mk8(r0, r1); o[1] = mk8(r2, r3); o[2] = mk8(r4, r5); o[3] = mk8(r6, r7);
}
static_assert(4 * SC_RS == 1088, "lds_tr8x4 immediates assume a 272-byte row stride");
__device__ __forceinline__ bf16x8 pack8(const f32x4 a, const f32x4 b) { const v4u t = (v4u){pk2c(a[0], a[1]), pk2c(a[2], a[3]), pk2c(b[0], b[1]), pk2c(b[2], b[3])}; return __builtin_bit_cast(bf16x8, t); }
#define DPP_SCAN_STEP(v, ctrl, rmask) do { const int t_ = __builtin_amdgcn_update_dpp(0, __builtin_bit_cast(int, v), (ctrl), (rmask), 0xf, false); v += __builtin_bit_cast(float, t_); } while (0)
__device__ __forceinline__ void ssd_scan_mfma_phase(const Frame& F, KArgs a, int j) {
    const bf16* XBC = (const bf16*)(a->ws + WS_XBC); bf16* YB = (bf16*)(a->ws + WS_YB);
    const float* DT = (const float*)(a->ws + WS_DT);
    const unsigned ldsb = (unsigned)(size_t)F.lds;
    const int hl = F.wave >> 2, pq = F.wave & 3, r = F.lane & 15, q = F.lane >> 4;
    const int ch0 = hl * 64 + pq * 16;
    LAS float* PRIV = (LAS float*)(F.lds + SC_PRIV + F.wave * 1024);
    LAS float* ACS = PRIV; LAS float* DTV = PRIV + 64; LAS float* EA = PRIV + 128; LAS float* WB = PRIV + 192;
    LAS float* ACSo = (LAS float*)(F.lds + SC_CB + 10240 + F.wave * 512); LAS float* DTVo = ACSo + 64;
    const int tq = (F.lane & 15) >> 2, tp = F.lane & 3;
    for (int unit = blockIdx.x; unit < BATCH * NG * 8; unit += F.G) {
        const int b = unit >> 6, g = (unit >> 3) & 7, e = unit & 7, hg0 = g * 16 + 2 * e, hg = hg0 + hl;
        const float aneg = -__expf(a->in[5][j * NH + hg]); const float dsk = a->in[6][j * NH + hg]; const float anego = -__expf(a->in[5][j * NH + (hg ^ 1)]);
        f32x4 S[8];
#pragma unroll
        for (int n = 0; n < 8; ++n) S[n] = (f32x4){0.f, 0.f, 0.f, 0.f};
        v4u pre[6]; float pdt, pdo;
        unsigned vo0 = (unsigned)(((F.tid >> 4) * CONVD + (F.tid & 15) * 8) * 2); asm volatile("" : "+v"(vo0));
        const unsigned vdt = (unsigned)(F.lane * NH * 4);
#define SCM_LOAD(c_) do { const size_t t0_ = (size_t)b * SEQ + (size_t)(c_) * 64; const char* pB = (const char*)(XBC + t0_ * CONVD + DI + g * NST); const char* pC = pB + NG * NST * 2; const char* pX = (const char*)(XBC + t0_ * CONVD + hg0 * HD); \
            _Pragma("unroll") for (int k = 0; k < 2; ++k) { pre[k] = *(const v4u*)(pB + (size_t)k * 32 * CONVD * 2 + vo0); pre[2 + k] = *(const v4u*)(pC + (size_t)k * 32 * CONVD * 2 + vo0); pre[4 + k] = *(const v4u*)(pX + (size_t)k * 32 * CONVD * 2 + vo0); } \
            pdt = *(const float*)((const char*)(DT + t0_ * NH + hg) + vdt); pdo = *(const float*)((const char*)(DT + t0_ * NH + (hg ^ 1)) + vdt); } while (0)
#define SCM_STORE(stage_) do { _Pragma("unroll") for (int k = 0; k < 2; ++k) { const int piece = F.tid + 512 * k, row = piece >> 4, c16 = piece & 15; LAS unsigned char* d = F.lds + (stage_) * SC_STAGE + row * SC_RS + c16 * 16; \
                *(LAS v4u*)(d) = pre[k]; *(LAS v4u*)(d + SC_TILE) = pre[2 + k]; *(LAS v4u*)(d + 2 * SC_TILE) = pre[4 + k]; } } while (0)
        __syncthreads();
        SCM_LOAD(0); SCM_STORE(0);
        float dtc = pdt, dto = pdo;
        __syncthreads();
        for (int c = 0; c < SEQ / 64; ++c) {
            const int st = c & 1; const size_t t0 = (size_t)b * SEQ + (size_t)c * 64;
            if (c + 1 < SEQ / 64) SCM_LOAD(c + 1);
            v4u zpre[2];
            { const char* pZ = (const char*)((const bf16*)(a->ws + WS_ZX) + t0 * PROJP + hg0 * HD); const unsigned vz = (unsigned)(((F.tid >> 4) * PROJP + (F.tid & 15) * 8) * 2);
#pragma unroll
              for (int k = 0; k < 2; ++k) zpre[k] = *(const v4u*)(pZ + (size_t)k * 32 * PROJP * 2 + vz); }
            const unsigned Bb = ldsb + st * SC_STAGE, Cb = Bb + SC_TILE, Xb = Bb + 2 * SC_TILE;
            LAS unsigned char* Bp = F.lds + st * SC_STAGE; LAS unsigned char* Cp = Bp + SC_TILE;
            { float acs = dtc * aneg;
              DPP_SCAN_STEP(acs, 0x111, 0xf); DPP_SCAN_STEP(acs, 0x112, 0xf); DPP_SCAN_STEP(acs, 0x114, 0xf); DPP_SCAN_STEP(acs, 0x118, 0xf);
              DPP_SCAN_STEP(acs, 0x142, 0xa); DPP_SCAN_STEP(acs, 0x143, 0xc);
              const float a63 = __builtin_bit_cast(float, __builtin_amdgcn_readlane(__builtin_bit_cast(int, acs), 63));
              ACS[F.lane] = acs; DTV[F.lane] = dtc; EA[F.lane] = __expf(acs); WB[F.lane] = __expf(a63 - acs) * dtc;
              float aco = dto * anego;
              DPP_SCAN_STEP(aco, 0x111, 0xf); DPP_SCAN_STEP(aco, 0x112, 0xf); DPP_SCAN_STEP(aco, 0x114, 0xf); DPP_SCAN_STEP(aco, 0x118, 0xf);
              DPP_SCAN_STEP(aco, 0x142, 0xa); DPP_SCAN_STEP(aco, 0x143, 0xc);
              ACSo[F.lane] = aco; DTVo[F.lane] = dto; }
            const float eT = __expf(__builtin_bit_cast(float, __builtin_amdgcn_readlane(__builtin_bit_cast(int, ACS[63]), 0)));
            asm volatile("s_waitcnt lgkmcnt(0)" ::: "memory");
            f32x4 yacc[4];
#pragma unroll
            for (int lt = 0; lt < 4; ++lt) yacc[lt] = (f32x4){0.f, 0.f, 0.f, 0.f};
#pragma unroll
            for (int kn = 0; kn < 4; ++kn) {
                const bf16x8 sb = pack8(S[2 * kn], S[2 * kn + 1]);
#pragma unroll
                for (int lt = 0; lt < 4; ++lt) {
                    const LAS unsigned char* cr = Cp + (16 * lt + r) * SC_RS + (32 * kn + 4 * q) * 2;
                    const v2u c0 = *(const LAS v2u*)(cr), c1 = *(const LAS v2u*)(cr + 32);
                    yacc[lt] = __builtin_amdgcn_mfma_f32_16x16x32_bf16(mk8(c0, c1), sb, yacc[lt], 0, 0, 0);
                }
            }
#pragma unroll
            for (int lt = 0; lt < 4; ++lt) { const f32x4 ea = *(const LAS f32x4*)(EA + 16 * lt + 4 * q); yacc[lt] = yacc[lt] * ea; }
#pragma unroll
            for (int rep = 0; rep < 2; ++rep) { const int tile = F.wave + 8 * rep;
                if (tile < 10) { const int tl = tile < 1 ? 0 : (tile < 3 ? 1 : (tile < 6 ? 2 : 3)), ts = tile - (tl * (tl + 1)) / 2;
                    f32x4 cb = (f32x4){0.f, 0.f, 0.f, 0.f};
#pragma unroll
                    for (int kn = 0; kn < 4; ++kn) {
                        const bf16x8 af = *(const LAS bf16x8*)(Bp + (16 * ts + r) * SC_RS + (32 * kn + 8 * q) * 2);
                        const bf16x8 bfr = *(const LAS bf16x8*)(Cp + (16 * tl + r) * SC_RS + (32 * kn + 8 * q) * 2);
                        cb = __builtin_amdgcn_mfma_f32_16x16x32_bf16(af, bfr, cb, 0, 0, 0); }
#pragma unroll
                    for (int h = 0; h < 2; ++h) { const LAS float* Ah = (h == hl) ? ACS : ACSo; const LAS float* Dh = (h == hl) ? DTV : DTVo;
                        const float acl = Ah[16 * tl + r]; const f32x4 as4 = *(const LAS f32x4*)(Ah + 16 * ts + 4 * q), dt4 = *(const LAS f32x4*)(Dh + 16 * ts + 4 * q);
                        f32x4 w;
#pragma unroll
                        for (int i = 0; i < 4; ++i) { const float ex = __expf(fminf(acl - as4[i], 0.f)) * dt4[i]; w[i] = (ts < tl || 4 * q + i <= r) ? cb[i] * ex : 0.f; }
                        *(LAS v2u*)(F.lds + SC_CB + (h * 10 + tile) * 512 + F.lane * 8) = (v2u){pk2c(w[0], w[1]), pk2c(w[2], w[3])}; } } }
            __syncthreads();
            bf16x8 xk[2];
#pragma unroll
            for (int ks = 0; ks < 2; ++ks) { const unsigned ad = Xb + (32 * ks + 4 * q + tq) * SC_RS + (ch0 + 4 * tp) * 2; xk[ks] = lds_tr8(ad, ad + 16 * SC_RS); }
#pragma unroll
            for (int lt = 0; lt < 4; ++lt) {
                v2u wt[4];
#pragma unroll
                for (int st2 = 0; st2 < 4; ++st2) wt[st2] = (st2 <= lt) ? *(const LAS v2u*)(F.lds + SC_CB + (hl * 10 + (lt * (lt + 1)) / 2 + st2) * 512 + F.lane * 8) : (v2u){0u, 0u};
                yacc[lt] = __builtin_amdgcn_mfma_f32_16x16x32_bf16(mk8(wt[0], wt[1]), xk[0], yacc[lt], 0, 0, 0);
                if (lt >= 2) yacc[lt] = __builtin_amdgcn_mfma_f32_16x16x32_bf16(mk8(wt[2], wt[3]), xk[1], yacc[lt], 0, 0, 0);
            }
#pragma unroll
            for (int lt = 0; lt < 4; ++lt) {
                const v2u xv = lds_tr2(Xb + (16 * lt + 4 * q + tq) * SC_RS + (ch0 + 4 * tp) * 2);
                const float x0 = bf_lo(xv.x), x1 = bf_hi(xv.x), x2 = bf_lo(xv.y), x3 = bf_hi(xv.y);
                const f32x4 y = yacc[lt] + (f32x4){x0, x1, x2, x3} * dsk;
                LAS unsigned short* yp = (LAS unsigned short*)(F.lds + SC_YS + (16 * lt + 4 * q) * SC_RS + (ch0 + r) * 2);
                const unsigned p01 = pk2c(y[0], y[1]), p23 = pk2c(y[2], y[3]);
                yp[0] = (unsigned short)(p01 & 0xffffu); yp[SC_RS / 2] = (unsigned short)(p01 >> 16); yp[SC_RS] = (unsigned short)(p23 & 0xffffu); yp[3 * SC_RS / 2] = (unsigned short)(p23 >> 16);
            }
#pragma unroll
            for (int n = 0; n < 8; ++n) S[n] = S[n] * eT;
#pragma unroll
            for (int ks = 0; ks < 2; ++ks) {
                const unsigned xa = Xb + (32 * ks + 8 * q + tq) * SC_RS + (ch0 + 4 * tp) * 2;
                const v2u xa0 = lds_tr2(xa), xa1 = lds_tr2(xa + 4 * SC_RS);
                const f32x4 w0 = *(const LAS f32x4*)(WB + 32 * ks + 8 * q), w1 = *(const LAS f32x4*)(WB + 32 * ks + 8 * q + 4);
                const f32x4 xs0 = (f32x4){bf_lo(xa0.x) * w0[0], bf_hi(xa0.x) * w0[1], bf_lo(xa0.y) * w0[2], bf_hi(xa0.y) * w0[3]};
                const f32x4 xs1 = (f32x4){bf_lo(xa1.x) * w1[0], bf_hi(xa1.x) * w1[1], bf_lo(xa1.y) * w1[2], bf_hi(xa1.y) * w1[3]};
                const bf16x8 xf = pack8(xs0, xs1);
#pragma unroll
                for (int ng = 0; ng < 2; ++ng) {
                    bf16x8 bt[4];
                    lds_tr8x4(Bb + (32 * ks + 8 * q + tq) * SC_RS + (64 * ng + 4 * tp) * 2, bt);
#pragma unroll
                    for (int n4 = 0; n4 < 4; ++n4) S[4 * ng + n4] = __builtin_amdgcn_mfma_f32_16x16x32_bf16(bt[n4], xf, S[4 * ng + n4], 0, 0, 0);
                }
            }
            if (c + 1 < SEQ / 64) { SCM_STORE(st ^ 1); dtc = pdt; dto = pdo; }
            __syncthreads();
            { char* yb = (char*)(YB + t0 * DI + hg0 * HD); const unsigned yo = (unsigned)(((F.tid >> 4) * DI + (F.tid & 15) * 8) * 2);
              unsigned long long* ssp = (unsigned long long*)(a->ws + WS_SS) + ((size_t)j * T + t0) * NG + g;
#pragma unroll
              for (int k = 0; k < 2; ++k) { const int piece = F.tid + 512 * k, row = piece >> 4, c16 = piece & 15;
                const v4u v = *(const LAS v4u*)(F.lds + SC_YS + row * SC_RS + c16 * 16); const v4u zv = zpre[k];
                float hh[8]; float ssq = 0.f;
#pragma unroll
                for (int e = 0; e < 4; ++e) { hh[2 * e] = bf_lo(v[e]) * silu_f(bf_lo(zv[e])); hh[2 * e + 1] = bf_hi(v[e]) * silu_f(bf_hi(zv[e])); ssq += hh[2 * e] * hh[2 * e] + hh[2 * e + 1] * hh[2 * e + 1]; }
                { const int t1 = __builtin_amdgcn_update_dpp(0, __builtin_bit_cast(int, ssq), 0xB1, 0xf, 0xf, false); ssq += __builtin_bit_cast(float, t1); }
                { const int t1 = __builtin_amdgcn_update_dpp(0, __builtin_bit_cast(int, ssq), 0x4E, 0xf, 0xf, false); ssq += __builtin_bit_cast(float, t1); }
                { const int t1 = __builtin_amdgcn_update_dpp(0, __builtin_bit_cast(int, ssq), 0x141, 0xf, 0xf, false); ssq += __builtin_bit_cast(float, t1); }
                { const int t1 = __builtin_amdgcn_update_dpp(0, __builtin_bit_cast(int, ssq), 0x140, 0xf, 0xf, false); ssq += __builtin_bit_cast(float, t1); }
                if (c16 == 0) atomicAdd(ssp + (size_t)row * NG, (unsigned long long)(ssq * 1048576.f + 0.5f));
                v4u ho; ho.x = pk2c(hh[0], hh[1]); ho.y = pk2c(hh[2], hh[3]); ho.z = pk2c(hh[4], hh[5]); ho.w = pk2c(hh[6], hh[7]);
                *(v4u*)(yb + (size_t)k * 32 * DI * 2 + yo) = ho; } }
            __syncthreads();
        }
#undef SCM_LOAD
#undef SCM_STORE
    }
}

__device__ __forceinline__ void ssd_ratio_phase(const Frame& F, KArgs a, int j) {
    const unsigned long long* SS = (const unsigned long long*)(a->ws + WS_SS) + (size_t)j * T * NG; float* RAT = (float*)(a->ws + WS_RAT);
    const size_t gtid = (size_t)blockIdx.x * NTHREADS + F.tid, nthr = (size_t)F.G * NTHREADS;
    for (size_t i = gtid; i < (size_t)T * NG; i += nthr) { const int g = (int)(i & 7);
        const float sc = 1.0f / (1048576.f * 1024.f);
        if (g == 0) RAT[i] = 1.0f / sqrtf((float)SS[i + 7] * sc + RMS_EPS);
        else RAT[i] = sqrtf(((float)SS[i] * sc + RMS_EPS) / ((float)SS[i - 1] * sc + RMS_EPS)); }
}

__device__ __forceinline__ void ssd_gate_phase(const Frame& F, KArgs a, int j) {
    const bf16* ZX = (const bf16*)(a->ws + WS_ZX); const bf16* YB = (const bf16*)(a->ws + WS_YB); bf16* HB = (bf16*)(a->ws + WS_XBC);
    const float* nw = a->in[7] + (size_t)j * DI;
    for (int it0 = F.gw; it0 < T * NG; it0 += 2 * F.NGW) {
        v4u yv[2][2], zv[2][2];
#pragma unroll
        for (int u = 0; u < 2; ++u) { const int it = it0 + u * F.NGW; const int t = it >> 3, g = it & 7, c = g * 1024 + F.lane * 8;
#pragma unroll
            for (int q = 0; q < 2; ++q) { yv[u][q] = *(const v4u*)(YB + (size_t)t * DI + c + 512 * q); zv[u][q] = *(const v4u*)(ZX + (size_t)t * PROJP + c + 512 * q); } }
#pragma unroll
        for (int u = 0; u < 2; ++u) { const int it = it0 + u * F.NGW; const int t = it >> 3, g = it & 7, c = g * 1024 + F.lane * 8;
            float h[16]; float ss = 0.f;
#pragma unroll
            for (int q = 0; q < 2; ++q)
#pragma unroll
                for (int e = 0; e < 4; ++e) { const float y0 = bf_lo(yv[u][q][e]), y1 = bf_hi(yv[u][q][e]), z0 = bf_lo(zv[u][q][e]), z1 = bf_hi(zv[u][q][e]);
                    const float h0 = y0 * silu_f(z0), h1 = y1 * silu_f(z1); h[8 * q + 2 * e] = h0; h[8 * q + 2 * e + 1] = h1; ss += h0 * h0 + h1 * h1; }
            ss = wave_sum(ss);
            const float rstd = 1.0f / sqrtf(ss * (1.0f / 1024.f) + RMS_EPS);
#pragma unroll
            for (int q = 0; q < 2; ++q) {
                const f32x4 w0 = *(const f32x4*)(nw + c + 512 * q), w1 = *(const f32x4*)(nw + c + 512 * q + 4);
                v4u o; o.x = pk2(h[8 * q + 0] * rstd * w0[0], h[8 * q + 1] * rstd * w0[1]); o.y = pk2(h[8 * q + 2] * rstd * w0[2], h[8 * q + 3] * rstd * w0[3]);
                o.z = pk2(h[8 * q + 4] * rstd * w1[0], h[8 * q + 5] * rstd * w1[1]); o.w = pk2(h[8 * q + 6] * rstd * w1[2], h[8 * q + 7] * rstd * w1[3]);
                *(v4u*)(HB + (size_t)t * DI + c + 512 * q) = o;
            }
        }
    }
}

__device__ __forceinline__ void sc_conv_phase(const Frame& F, KArgs a, int j) {
    const bf16* BCH = (const bf16*)(a->ws + WS_ZX); bf16* YC = (bf16*)(a->ws + WS_XBC);
    const float* cw = a->in[10] + (size_t)j * 3 * D;
    constexpr int NCB = D / 512, NITEMS = (T / 32) * NCB, LDB = 3 * D;
    for (int it = F.gw; it < NITEMS; it += F.NGW) {
        const int tb = it / NCB, cbk = it % NCB, c0 = cbk * 512 + F.lane * 8, t0 = tb * 32;
        float w[3][8];
#pragma unroll
        for (int k = 0; k < 3; ++k) { const f32x4 u0 = *(const f32x4*)(cw + (size_t)k * D + c0), u1 = *(const f32x4*)(cw + (size_t)k * D + c0 + 4);
#pragma unroll
            for (int e = 0; e < 4; ++e) { w[k][e] = u0[e]; w[k][4 + e] = u1[e]; } }
        float p0[8], p1[8];
        const bool head = (t0 % SEQ) == 0;
#pragma unroll
        for (int h = 0; h < 2; ++h) {
            v4u gc = (v4u){0u, 0u, 0u, 0u}, hh = (v4u){0u, 0u, 0u, 0u};
            if (!head) { gc = *(const v4u*)(BCH + (size_t)(t0 - 2 + h) * LDB + D + c0); hh = *(const v4u*)(BCH + (size_t)(t0 - 2 + h) * LDB + 2 * D + c0); }
            float* dst = h == 0 ? p0 : p1;
#pragma unroll
            for (int e = 0; e < 4; ++e) { dst[2 * e] = bf_lo(gc[e]) * bf_lo(hh[e]); dst[2 * e + 1] = bf_hi(gc[e]) * bf_hi(hh[e]); }
        }
        for (int tt0 = 0; tt0 < 32; tt0 += 4) {
            v4u gbv[4], gcv[4], hhv[4];
#pragma unroll
            for (int k = 0; k < 4; ++k) { const bf16* rowp = BCH + (size_t)(t0 + tt0 + k) * LDB + c0; gbv[k] = __builtin_nontemporal_load((const v4u*)(rowp)); gcv[k] = __builtin_nontemporal_load((const v4u*)(rowp + D)); hhv[k] = __builtin_nontemporal_load((const v4u*)(rowp + 2 * D)); }
#pragma unroll
            for (int k = 0; k < 4; ++k) {
                const v4u gb = gbv[k], gc = gcv[k], hh = hhv[k];
                float cur[8], o[8], gbf[8];
#pragma unroll
                for (int e = 0; e < 4; ++e) { cur[2 * e] = bf_lo(gc[e]) * bf_lo(hh[e]); cur[2 * e + 1] = bf_hi(gc[e]) * bf_hi(hh[e]); gbf[2 * e] = bf_lo(gb[e]); gbf[2 * e + 1] = bf_hi(gb[e]); }
#pragma unroll
                for (int e = 0; e < 8; ++e) { o[e] = gbf[e] * (w[0][e] * p0[e] + w[1][e] * p1[e] + w[2][e] * cur[e]); p0[e] = p1[e]; p1[e] = cur[e]; }
                v4u ov; ov.x = pk2(o[0], o[1]); ov.y = pk2(o[2], o[3]); ov.z = pk2(o[4], o[5]); ov.w = pk2(o[6], o[7]);
                __builtin_nontemporal_store(ov, (v4u*)(YC + (size_t)(t0 + tt0 + k) * D + c0));
            }
        }
    }
}

__device__ __forceinline__ void ln_phase(const Frame& F, const float* Y32, float* X32, bf16* XB, const float* gam, const float* bet) {
    for (int m = F.gw; m < T; m += F.NGW) {
        const f32x4* xr = (const f32x4*)(Y32 + (size_t)m * D) + F.lane;
        f32x4 v[16]; float s = 0.f;
#pragma unroll
        for (int q = 0; q < 16; ++q) { v[q] = xr[64 * q]; s += (v[q][0] + v[q][1]) + (v[q][2] + v[q][3]); }
        const float mean = wave_sum(s) * (1.f / D); float s2 = 0.f;
#pragma unroll
        for (int q = 0; q < 16; ++q) { v[q] = v[q] - mean; s2 += (v[q][0] * v[q][0] + v[q][1] * v[q][1]) + (v[q][2] * v[q][2] + v[q][3] * v[q][3]); }
        const float rstd = 1.f / sqrtf(wave_sum(s2) * (1.f / D) + LN_EPS);
        f32x4* o4 = (f32x4*)(X32 + (size_t)m * D) + F.lane; unsigned long long* o8 = (unsigned long long*)(XB + (size_t)m * D) + F.lane;
#pragma unroll
        for (int q = 0; q < 16; ++q) { const f32x4 gg = ((const f32x4*)gam)[F.lane + 64 * q], bb = ((const f32x4*)bet)[F.lane + 64 * q];
            const f32x4 o = v[q] * rstd * gg + bb; o4[64 * q] = o;
            o8[64 * q] = (unsigned long long)pk2(o[0], o[1]) | ((unsigned long long)pk2(o[2], o[3]) << 32); }
    }
}

constexpr int TK_TAB = RING_BYTES + 1024;
__device__ __forceinline__ unsigned f2sort(float f) { const unsigned u = __float_as_uint(f); return u ^ (((int)u >> 31) | 0x80000000u); }
__device__ __forceinline__ float sort2f(unsigned k) { const unsigned u = (k & 0x80000000u) ? (k ^ 0x80000000u) : ~k; return __uint_as_float(u); }
#define DPP_UMAX_ROW(v) do { \
    { const unsigned t_ = (unsigned)__builtin_amdgcn_update_dpp((int)(v), (int)(v), 0xB1, 0xf, 0xf, false); v = v > t_ ? v : t_; } \
    { const unsigned t_ = (unsigned)__builtin_amdgcn_update_dpp((int)(v), (int)(v), 0x4E, 0xf, 0xf, false); v = v > t_ ? v : t_; } \
    { const unsigned t_ = (unsigned)__builtin_amdgcn_update_dpp((int)(v), (int)(v), 0x141, 0xf, 0xf, false); v = v > t_ ? v : t_; } \
    { const unsigned t_ = (unsigned)__builtin_amdgcn_update_dpp((int)(v), (int)(v), 0x140, 0xf, 0xf, false); v = v > t_ ? v : t_; } } while (0)
#define DPP_FADD_ROW(v) do { \
    { const int t_ = __builtin_amdgcn_update_dpp(0, __builtin_bit_cast(int, v), 0xB1, 0xf, 0xf, false); v += __builtin_bit_cast(float, t_); } \
    { const int t_ = __builtin_amdgcn_update_dpp(0, __builtin_bit_cast(int, v), 0x4E, 0xf, 0xf, false); v += __builtin_bit_cast(float, t_); } \
    { const int t_ = __builtin_amdgcn_update_dpp(0, __builtin_bit_cast(int, v), 0x141, 0xf, 0xf, false); v += __builtin_bit_cast(float, t_); } \
    { const int t_ = __builtin_amdgcn_update_dpp(0, __builtin_bit_cast(int, v), 0x140, 0xf, 0xf, false); v += __builtin_bit_cast(float, t_); } } while (0)
__device__ __forceinline__ void peer_topk_phase(const Frame& F, KArgs a, int layer) {
    const float* Q32 = (const float*)(a->ws + WS_Q32); int* EIDX = (int*)(a->ws + WS_EIDX); float* GATES = (float*)(a->ws + WS_GATES);
    LAS float* KT = (LAS float*)F.lds;
    LAS unsigned char* TAB = (LAS unsigned char*)(F.lds + TK_TAB);
    const int r = F.lane & 15, q = F.lane >> 4, rowbase = F.lane & 48;
    if (F.tid < 64) { int n = 0, ca = 0, cb = 0; for (int aa = 0; aa < PK; ++aa) for (int bb = 0; bb < PK; ++bb) if ((aa + 1) * (bb + 1) <= PK) { if (n == F.tid) { ca = aa; cb = bb; } ++n; }
        TAB[F.tid] = (unsigned char)ca; TAB[64 + F.tid] = (unsigned char)cb; }
    __syncthreads();
    int cda[4], cdb[4];
#pragma unroll
    for (int c = 0; c < 4; ++c) { cda[c] = TAB[4 * r + c]; cdb[c] = TAB[64 + 4 * r + c]; }
    for (int unit = blockIdx.x; unit < PH * 32; unit += F.G) {
        const int h = unit >> 5, tr = unit & 31;
        const char* keys = (const char*)(a->in[13] + ((size_t)(layer * PH + h) * 2) * NK * HALFD);
        unsigned kvo = (unsigned)(((F.tid >> 4) * HALFD + (F.tid & 15) * 8) * 4); asm volatile("" : "+v"(kvo));
        __syncthreads();
#pragma unroll
        for (int i = 0; i < 2; ++i)
#pragma unroll
            for (int itx = 0; itx < 4; ++itx) { const int key = itx * 32 + (F.tid >> 4), ch = F.tid & 15;
                const f32x4 v0 = *(const f32x4*)(keys + (size_t)(i * NK * HALFD * 4 + itx * 32 * HALFD * 4) + kvo), v1 = *(const f32x4*)(keys + (size_t)(i * NK * HALFD * 4 + itx * 32 * HALFD * 4 + 16) + kvo);
                v4u hi, lo;
                hi.x = pk2c(v0[0], v0[1]); hi.y = pk2c(v0[2], v0[3]); hi.z = pk2c(v1[0], v1[1]); hi.w = pk2c(v1[2], v1[3]);
                lo.x = pk2c(v0[0] - bf_lo(hi.x), v0[1] - bf_hi(hi.x)); lo.y = pk2c(v0[2] - bf_lo(hi.y), v0[3] - bf_hi(hi.y)); lo.z = pk2c(v1[0] - bf_lo(hi.z), v1[1] - bf_hi(hi.z)); lo.w = pk2c(v1[2] - bf_lo(hi.w), v1[3] - bf_hi(hi.w));
                const int off = i * 32768 + key * 256 + ((ch ^ (key & 15)) << 4);
                *(LAS v4u*)(F.lds + off) = hi; *(LAS v4u*)(F.lds + 65536 + off) = lo; }
        __syncthreads();
        unsigned qvo = (unsigned)((r * QD + 8 * q) * 4); asm volatile("" : "+v"(qvo));
        const unsigned ovo = (unsigned)(((4 * q) * (PH * PK) + r) * 4);
        for (int batch = 0; batch < 4; ++batch) {
            const int t0 = tr * 512 + F.wave * 64 + batch * 16;
            f32x4 acc[2][8];
#pragma unroll
            for (int i = 0; i < 2; ++i) {
                const char* qp = (const char*)(Q32 + (size_t)t0 * QD + h * 256 + i * 128);
#pragma unroll
                for (int nt = 0; nt < 8; ++nt) acc[i][nt] = (f32x4){0.f, 0.f, 0.f, 0.f};
#pragma unroll
                for (int ks = 0; ks < 4; ++ks) {
                    const f32x4 q0 = *(const f32x4*)(qp + 128 * ks + qvo), q1 = *(const f32x4*)(qp + 128 * ks + 16 + qvo);
                    v4u ah, al;
                    ah.x = pk2c(q0[0], q0[1]); ah.y = pk2c(q0[2], q0[3]); ah.z = pk2c(q1[0], q1[1]); ah.w = pk2c(q1[2], q1[3]);
                    al.x = pk2c(q0[0] - bf_lo(ah.x), q0[1] - bf_hi(ah.x)); al.y = pk2c(q0[2] - bf_lo(ah.y), q0[3] - bf_hi(ah.y)); al.z = pk2c(q1[0] - bf_lo(ah.z), q1[1] - bf_hi(ah.z)); al.w = pk2c(q1[2] - bf_lo(ah.w), q1[3] - bf_hi(ah.w));
                    const bf16x8 Ah = __builtin_bit_cast(bf16x8, ah), Al = __builtin_bit_cast(bf16x8, al);
#pragma unroll
                    for (int nt = 0; nt < 8; ++nt) {
                        const int off = i * 32768 + (16 * nt + r) * 256 + (((4 * ks + q) ^ r) << 4);
                        const bf16x8 Bh = *(const LAS bf16x8*)(F.lds + off), Bl = *(const LAS bf16x8*)(F.lds + 65536 + off);
                        acc[i][nt] = __builtin_amdgcn_mfma_f32_16x16x32_bf16(Ah, Bh, acc[i][nt], 0, 0, 0);
                        acc[i][nt] = __builtin_amdgcn_mfma_f32_16x16x32_bf16(Al, Bh, acc[i][nt], 0, 0, 0);
                        acc[i][nt] = __builtin_amdgcn_mfma_f32_16x16x32_bf16(Ah, Bl, acc[i][nt], 0, 0, 0);
                    }
                    __builtin_amdgcn_sched_barrier(0);
                }
            }
#pragma unroll
            for (int e = 0; e < 4; ++e) {
                unsigned res[2];
#pragma unroll
                for (int i = 0; i < 2; ++i) {
                    unsigned key[8];
#pragma unroll
                    for (int nt = 0; nt < 8; ++nt) key[nt] = (f2sort(acc[i][nt][e]) & ~127u) | (unsigned)(127 - (16 * nt + r));
#define TK_CE(i_, j_) do { const unsigned hi_ = key[i_] > key[j_] ? key[i_] : key[j_], lo_ = key[i_] > key[j_] ? key[j_] : key[i_]; key[i_] = hi_; key[j_] = lo_; } while (0)
                    TK_CE(0, 1); TK_CE(2, 3); TK_CE(4, 5); TK_CE(6, 7); TK_CE(0, 2); TK_CE(1, 3); TK_CE(4, 6); TK_CE(5, 7); TK_CE(1, 2); TK_CE(5, 6);
                    TK_CE(0, 4); TK_CE(1, 5); TK_CE(2, 6); TK_CE(3, 7); TK_CE(2, 4); TK_CE(3, 5); TK_CE(1, 2); TK_CE(3, 4); TK_CE(5, 6);
#undef TK_CE
                    unsigned rs = 0u;
                    for (int step = 0; step < PK; ++step) {
                        unsigned m = key[0];
                        DPP_UMAX_ROW(m);
                        const bool won = (key[0] == m);
#pragma unroll
                        for (int nt = 0; nt < 7; ++nt) key[nt] = won ? key[nt + 1] : key[nt];
                        key[7] = won ? 0u : key[7];
                        rs = (r == step) ? m : rs;
                    }
                    res[i] = rs;
                }
                unsigned ck[4];
#pragma unroll
                for (int c = 0; c < 4; ++c) { const unsigned k1 = (unsigned)__shfl((int)res[0], rowbase + cda[c]), k2 = (unsigned)__shfl((int)res[1], rowbase + cdb[c]);
                    const float sv = sort2f(k1 & ~127u) + sort2f(k2 & ~127u); const int cid = 4 * r + c;
                    ck[c] = (cid < 50) ? ((f2sort(sv) & ~63u) | (unsigned)(63 - cid)) : 0u; }
#define TK_CE(i_, j_) do { const unsigned hi_ = ck[i_] > ck[j_] ? ck[i_] : ck[j_], lo_ = ck[i_] > ck[j_] ? ck[j_] : ck[i_]; ck[i_] = hi_; ck[j_] = lo_; } while (0)
                TK_CE(0, 1); TK_CE(2, 3); TK_CE(0, 2); TK_CE(1, 3); TK_CE(1, 2);
#undef TK_CE
                unsigned rs3 = 0u;
                for (int step = 0; step < PK; ++step) {
                    unsigned m = ck[0];
                    DPP_UMAX_ROW(m);
                    const bool won = (ck[0] == m);
                    ck[0] = won ? ck[1] : ck[0]; ck[1] = won ? ck[2] : ck[1]; ck[2] = won ? ck[3] : ck[2]; ck[3] = won ? 0u : ck[3];
                    rs3 = (r == step) ? m : rs3;
                }
                const int cid = 63 - (int)(rs3 & 63u); const float tv = sort2f(rs3 & ~63u);
                const int ta = TAB[cid], tb = TAB[64 + cid];
                const int i1 = 127 - (int)((unsigned)__shfl((int)res[0], rowbase + ta) & 127u), i2 = 127 - (int)((unsigned)__shfl((int)res[1], rowbase + tb) & 127u);
                const float mx = __shfl(tv, rowbase);
                const float ex = __expf(tv - mx); float sum = ex; DPP_FADD_ROW(sum);
                { char* ep = (char*)(EIDX + ((size_t)(t0 + e) * PH + h) * PK); char* gp = (char*)(GATES + ((size_t)(t0 + e) * PH + h) * PK);
                  *(int*)(ep + ovo) = i1 * NK + i2; *(float*)(gp + ovo) = ex / sum; }
            }
        }
    }
}

__device__ __forceinline__ float gelu_as(float v) {
    const float av = fabsf(v), t = __builtin_amdgcn_rcpf(av * 0.2316418882f + 1.0f);
    float q = t * 0.5307027145f + (-0.7265760135f); q = q * t + 0.7107068705f; q = q * t + (-0.142248368f); q = q * t + 0.127414796f; q = q * t;
    const float m = v * (q * __builtin_amdgcn_exp2f((v * v) * (-0.72134752044f)));
    return v < 0.f ? m : v - m;
}
#define FP4X2(w, b) __builtin_amdgcn_cvt_scalef32_pk_f32_fp4((w), 1.0f, (b))
__device__ __forceinline__ void peer_gather_phase(const Frame& F, KArgs a, int layer) {
    const char* U = (const char*)(a->ws + WS_W_U) + (size_t)layer * NEXP * D; const char* V = U + (D / 2);
    const float* RSU = (const float*)(a->ws + WS_RS) + (size_t)layer * NEXP; const float* RSV = RSU + 4 * NEXP;
    const int* EIDX = (const int*)(a->ws + WS_EIDX); const float* GATES = (const float*)(a->ws + WS_GATES);
    char* X32 = (char*)(a->ws + WS_X32); char* XB = (char*)(a->ws + WS_XB);
    const char* gam = (const char*)(a->in[18] + (size_t)layer * D); const char* bet = (const char*)(a->in[19] + (size_t)layer * D);
    const bool lastl = (layer == DEPTH - 1);
    char* OUT = lastl ? (char*)a->out : X32;
    const char* YBF = (const char*)(a->ws + WS_YBF);
    const int* S1 = (const int*)((const float*)(a->ws + WS_CTL) + CW_ST + layer * 2 * T); const int* S2 = S1 + T;
    LAS float* G1 = (LAS float*)F.lds; LAS float* B1 = G1 + D;
    __syncthreads();
    for (int i = F.tid; i < D / 4; i += NTHREADS) { ((LAS f32x4*)G1)[i] = ((const f32x4*)(a->in[16] + (size_t)layer * D))[i]; ((LAS f32x4*)B1)[i] = ((const f32x4*)(a->in[17] + (size_t)layer * D))[i]; }
    __syncthreads();
    for (int t = F.gw, trip = 0; trip < (T + F.NGW - 1) / F.NGW; ++trip, t += F.NGW) {
        __syncthreads();
        if (t >= T) continue;
        unsigned lo16 = F.lane * 16u; asm volatile("" : "+v"(lo16));
        const unsigned lo128 = lo16 * 8u;
        const char* xrow = YBF + (size_t)t * D * 2;
        const float mu1 = (float)S1[t] * (1.0f / (65536.f * D)); const float rs1 = 1.0f / sqrtf(fmaxf((float)S2[t] * (1.0f / (4096.f * D)) - mu1 * mu1, 0.f) + LN_EPS);
        f32x2 xp[32];
#pragma unroll
        for (int i = 0; i < 2; ++i)
#pragma unroll
            for (int k = 0; k < 8; ++k) { const v2u qb = __builtin_nontemporal_load((const v2u*)(xrow + i * 4096 + k * 512 + (lo16 >> 1))); const f32x4 q = (f32x4){bf_lo(qb.x), bf_hi(qb.x), bf_lo(qb.y), bf_hi(qb.y)};
                const f32x4 gq = *(const LAS f32x4*)((const LAS char*)G1 + i * 8192 + k * 1024 + lo16), bq = *(const LAS f32x4*)((const LAS char*)B1 + i * 8192 + k * 1024 + lo16);
                const f32x4 xv = (q - mu1) * rs1 * gq + bq; xp[i * 16 + 2 * k] = (f32x2){xv[0], xv[1]}; xp[i * 16 + 2 * k + 1] = (f32x2){xv[2], xv[3]}; }
        int ev0 = EIDX[(size_t)t * 128 + F.lane], ev1 = EIDX[(size_t)t * 128 + 64 + F.lane];
        float gv0 = GATES[(size_t)t * 128 + F.lane], gv1 = GATES[(size_t)t * 128 + 64 + F.lane];
        {
            int r0 = 0, r1 = 0;
            for (int jx = 0; jx < 64; ++jx) { const int ea = __builtin_amdgcn_readlane(ev0, jx), eb = __builtin_amdgcn_readlane(ev1, jx);
                r0 += (ea < ev0 || (ea == ev0 && jx < F.lane)) ? 1 : 0; r0 += (eb < ev0) ? 1 : 0;
                r1 += (ea < ev1 || ea == ev1) ? 1 : 0; r1 += (eb < ev1 || (eb == ev1 && jx < F.lane)) ? 1 : 0; }
            LAS int* se = (LAS int*)(F.lds + 32768 + F.wave * 1024); LAS float* sg = (LAS float*)(se + 128);
            se[r0] = ev0; sg[r0] = gv0; se[r1] = ev1; sg[r1] = gv1;
            asm volatile("s_waitcnt lgkmcnt(0)" ::: "memory");
            ev0 = se[F.lane]; ev1 = se[64 + F.lane]; gv0 = sg[F.lane]; gv1 = sg[64 + F.lane];
        }
        f32x2 ap[32];
#pragma unroll
        for (int k = 0; k < 32; ++k) ap[k] = (f32x2){0.f, 0.f};
        const float su0 = RSU[ev0], su1 = RSU[ev1]; gv0 *= RSV[ev0]; gv1 *= RSV[ev1];
#define GROW_LOAD(q, jn) do { const int en_ = __builtin_amdgcn_readlane((jn) < 64 ? ev0 : ev1, (jn) & 63); \
            const char* ur_ = U + (size_t)en_ * D; unsigned lo_ = lo16; asm volatile("" : "+v"(lo_)); uu[q][0] = *(const v4u*)(ur_ + lo_); uu[q][1] = *(const v4u*)(ur_ + 1024 + lo_); vv[q][0] = *(const v4u*)(ur_ + 2048 + lo_); vv[q][1] = *(const v4u*)(ur_ + 3072 + lo_); } while (0)
        v4u uu[4][2], vv[4][2]; float dep = 0.f;
#pragma unroll
        for (int q = 0; q < 4; ++q) GROW_LOAD(q, q);
        for (int jb = 0; jb < 32; ++jb) {
#pragma unroll
            for (int q = 0; q < 4; ++q) { const int jj = jb * 4 + q;
                const float gt = __builtin_bit_cast(float, __builtin_amdgcn_readlane(__builtin_bit_cast(int, jj < 64 ? gv0 : gv1), jj & 63));
                const float su = __builtin_bit_cast(float, __builtin_amdgcn_readlane(__builtin_bit_cast(int, jj < 64 ? su0 : su1), jj & 63));
                f32x2 s0 = (f32x2){0.f, 0.f}, s1 = (f32x2){0.f, 0.f};
#pragma unroll
                for (int i = 0; i < 2; ++i) { const v4u w4 = uu[q][i];
                    s0 += FP4X2(w4.x, 0) * xp[i * 16 + 0];  s1 += FP4X2(w4.x, 1) * xp[i * 16 + 1];  s0 += FP4X2(w4.x, 2) * xp[i * 16 + 2];  s1 += FP4X2(w4.x, 3) * xp[i * 16 + 3];
                    s0 += FP4X2(w4.y, 0) * xp[i * 16 + 4];  s1 += FP4X2(w4.y, 1) * xp[i * 16 + 5];  s0 += FP4X2(w4.y, 2) * xp[i * 16 + 6];  s1 += FP4X2(w4.y, 3) * xp[i * 16 + 7];
                    s0 += FP4X2(w4.z, 0) * xp[i * 16 + 8];  s1 += FP4X2(w4.z, 1) * xp[i * 16 + 9];  s0 += FP4X2(w4.z, 2) * xp[i * 16 + 10]; s1 += FP4X2(w4.z, 3) * xp[i * 16 + 11];
                    s0 += FP4X2(w4.w, 0) * xp[i * 16 + 12]; s1 += FP4X2(w4.w, 1) * xp[i * 16 + 13]; s0 += FP4X2(w4.w, 2) * xp[i * 16 + 14]; s1 += FP4X2(w4.w, 3) * xp[i * 16 + 15]; }
                float hq = wave_sum((s0[0] + s0[1]) + (s1[0] + s1[1])) * su; asm volatile("" : "+v"(hq) : "v"(dep));
                const float act = gelu_as(hq) * gt; dep = act;
                const f32x2 a2 = (f32x2){act, act};
                __builtin_amdgcn_sched_barrier(0);
#pragma unroll
                for (int i = 0; i < 2; ++i) { const v4u w4 = vv[q][i];
                    ap[i * 16 + 0] += a2 * FP4X2(w4.x, 0);  ap[i * 16 + 1] += a2 * FP4X2(w4.x, 1);  ap[i * 16 + 2] += a2 * FP4X2(w4.x, 2);  ap[i * 16 + 3] += a2 * FP4X2(w4.x, 3);
                    ap[i * 16 + 4] += a2 * FP4X2(w4.y, 0);  ap[i * 16 + 5] += a2 * FP4X2(w4.y, 1);  ap[i * 16 + 6] += a2 * FP4X2(w4.y, 2);  ap[i * 16 + 7] += a2 * FP4X2(w4.y, 3);
                    __builtin_amdgcn_sched_barrier(0);
                    ap[i * 16 + 8] += a2 * FP4X2(w4.z, 0);  ap[i * 16 + 9] += a2 * FP4X2(w4.z, 1);  ap[i * 16 + 10] += a2 * FP4X2(w4.z, 2); ap[i * 16 + 11] += a2 * FP4X2(w4.z, 3);
                    ap[i * 16 + 12] += a2 * FP4X2(w4.w, 0); ap[i * 16 + 13] += a2 * FP4X2(w4.w, 1); ap[i * 16 + 14] += a2 * FP4X2(w4.w, 2); ap[i * 16 + 15] += a2 * FP4X2(w4.w, 3);
                    __builtin_amdgcn_sched_barrier(0); }
                { const int jn = jj + 4 < 128 ? jj + 4 : 127; GROW_LOAD(q, jn); }
                __builtin_amdgcn_sched_barrier(0);
            }
        }
#undef GROW_LOAD
        f32x2 sp = (f32x2){0.f, 0.f};
#pragma unroll
        for (int k = 0; k < 32; ++k) { ap[k] += xp[k] * ALPHA; sp += ap[k]; }
        const float mean = wave_sum(sp[0] + sp[1]) * (1.f / D); f32x2 s2 = (f32x2){0.f, 0.f};
#pragma unroll
        for (int k = 0; k < 32; ++k) { ap[k] -= mean; s2 += ap[k] * ap[k]; }
        const float rstd = 1.f / sqrtf(wave_sum(s2[0] + s2[1]) * (1.f / D) + LN_EPS);
        char* orow = OUT + (size_t)t * D * 4; char* obrow = XB + (size_t)t * D * 2;
        const unsigned lo64 = lo16 * 4u;
#pragma unroll
        for (int i = 0; i < 2; ++i) {
#pragma unroll
            for (int kk = 0; kk < 8; ++kk) {
                const f32x4 g = *(const f32x4*)(gam + i * 8192 + kk * 1024 + lo16), b = *(const f32x4*)(bet + i * 8192 + kk * 1024 + lo16);
                const f32x2 o0 = ap[i * 16 + 2 * kk] * rstd * (f32x2){g[0], g[1]} + (f32x2){b[0], b[1]}, o1 = ap[i * 16 + 2 * kk + 1] * rstd * (f32x2){g[2], g[3]} + (f32x2){b[2], b[3]};
                if (lastl) __builtin_nontemporal_store((f32x4){o0[0], o0[1], o1[0], o1[1]}, (f32x4*)(orow + i * 8192 + kk * 1024 + lo16));
                else *(v2u*)(obrow + i * 4096 + kk * 512 + (lo16 >> 1)) = (v2u){pk2(o0[0], o0[1]), pk2(o1[0], o1[1])};
                if ((kk & 3) == 3) asm volatile("" ::: "memory");
            }
        }
    }
}

constexpr int NPHASE = 1 + 10 * DEPTH;
__global__ void __launch_bounds__(NTHREADS, 2) mk_fwd(Args args) {
    extern __shared__ __attribute__((aligned(16))) unsigned char lds[];
    Frame F;
#define NEWFRAME() do { int t_ = threadIdx.x; asm volatile("" : "+v"(t_)); F.lds = (LAS unsigned char*)lds; F.tid = t_; F.lane = t_ & 63; F.wave = __builtin_amdgcn_readfirstlane(t_ >> 6); \
        F.G = gridDim.x; F.gw = blockIdx.x * NWAVES + F.wave; F.NGW = F.G * NWAVES; } while (0)
    NEWFRAME();
    for (int u = F.tid; u < (LDS_BYTES - LDSCTL_OFF) / 4; u += NTHREADS) ((LAS unsigned*)(F.lds + LDSCTL_OFF))[u] = 0u;
    __syncthreads();
    volatile LAS unsigned* MISC = (volatile LAS unsigned*)(F.lds + MISC_OFF);
    if (args.use_bar) (void)xcd_barrier_post((unsigned*)(KA()->ws + WS_CTL) + CW_BAR, MISC + 8);
    const int lo = args.ph_lo, hi = args.ph_hi;
#define IN(k) (lo <= (k) && (k) < hi)
#define SEAM(k) do { if (args.use_bar && (k) + 1 < hi) { XcdBarrier bar_; bar_.bar = (unsigned*)(KA()->ws + WS_CTL) + CW_BAR; bar_.x = xb_xcc_id(); bar_.st = (volatile LAS unsigned*)((LAS unsigned char*)lds + MISC_OFF) + 8; xcd_barrier(bar_); } } while (0)

    if (IN(0)) { NEWFRAME(); p0_prologue(F, KA()); SEAM(0); }

    for (int layer = 0; layer < DEPTH; ++layer) {
        const int pb = 1 + 10 * layer, j = layer >> 1;

        if ((layer & 1) == 0) {
            if (IN(pb + 0)) {
                unsigned char* ws = KA()->ws; pg8::Gemm g{(const bf16*)(ws + WS_XB), (const bf16*)(ws + WS_W_SSD_IN + j * SZ_W_SSD_IN), T, PROJM, D, D}; pg8::StaticOrder S; S.init(T, PROJM, F.G, (int)blockIdx.x);
                pg8::EpiBf16 E{(bf16*)(ws + WS_ZX), PROJP};
                pg8::gemm_phase<pg8::EpiBf16, pg8::StaticOrder, true, true>(F.lds, g, S, E);
                {
                    unsigned char* ws2 = KA()->ws; pg8::Gemm g2{(const bf16*)(ws2 + WS_XB), (const bf16*)(ws2 + WS_W_SSD_IN + j * SZ_W_SSD_IN) + (size_t)PROJM * D, T, 256, D / 4, D};
                    pg8::SplitK4Order S2; S2.init(T, D / 4, F.G, (int)blockIdx.x); pg8::EpiDt E2{j};
                    pg8::gemm_phase<pg8::EpiDt, pg8::SplitK4Order, true, true>(F.lds, g2, S2, E2); }
                SEAM(pb + 0);
            }
            if (IN(pb + 1)) { NEWFRAME(); ssd_conv_phase(F, KA(), j); SEAM(pb + 1); }
            if (IN(pb + 2)) { NEWFRAME(); ssd_scan_mfma_phase(F, KA(), j); SEAM(pb + 2); }
            if (IN(pb + 3)) { NEWFRAME(); ssd_ratio_phase(F, KA(), j); SEAM(pb + 3); }
            if (IN(pb + 4)) {
                unsigned char* ws = KA()->ws; pg8::Gemm g{(const bf16*)(ws + WS_YB), (const bf16*)(ws + WS_W_SSD_OUT + j * SZ_W_SSD_OUT), T, D, DI / NG, DI}; pg8::Group8Order S; S.init(T, D, F.G, (int)blockIdx.x, DI / NG);
                pg8::EpiResS<true> E{layer, D, ALPHA};
                pg8::gemm_phase<pg8::EpiResS<true>, pg8::Group8Order, true, true>(F.lds, g, S, E);
                SEAM(pb + 4);
            }
        } else {
            if (IN(pb + 0)) {
                unsigned char* ws = KA()->ws; pg8::Gemm g{(const bf16*)(ws + WS_XB), (const bf16*)(ws + WS_W_SC_IN + j * SZ_W_SC_IN), T, 3 * D, D, D}; pg8::StaticOrder S; S.init(T, 3 * D, F.G, (int)blockIdx.x);
                pg8::EpiBf16 E{(bf16*)(ws + WS_ZX), 3 * D};
                pg8::gemm_phase<pg8::EpiBf16, pg8::StaticOrder, true, true>(F.lds, g, S, E);
                SEAM(pb + 0);
            }
            if (IN(pb + 1)) { NEWFRAME(); sc_conv_phase(F, KA(), j); SEAM(pb + 1); }
            if (IN(pb + 4)) {
                unsigned char* ws = KA()->ws; pg8::Gemm g{(const bf16*)(ws + WS_XBC), (const bf16*)(ws + WS_W_SC_OUT + j * SZ_W_SC_OUT), T, D, D, D}; pg8::StaticOrder S; S.init(T, D, F.G, (int)blockIdx.x);
                pg8::EpiResS<false> E{layer, D, ALPHA};
                pg8::gemm_phase<pg8::EpiResS<false>, pg8::StaticOrder, true, true>(F.lds, g, S, E);
                SEAM(pb + 4);
            }
        }
        if (IN(pb + 6)) {
            unsigned char* ws = KA()->ws; pg8::Gemm g{(const bf16*)(ws + WS_YBF), (const bf16*)(ws + WS_W_WQ + layer * SZ_W_WQ), T, QD, D, D}; pg8::StaticOrder S; S.init(T, QD, F.G, (int)blockIdx.x);
            pg8::EpiQ E{layer, QD, 1.0f / D, LN_EPS};
            pg8::gemm_phase<pg8::EpiQ, pg8::StaticOrder, true, true>(F.lds, g, S, E);
            SEAM(pb + 6);
        }
        if (IN(pb + 7)) { NEWFRAME(); peer_topk_phase(F, KA(), layer); SEAM(pb + 7); }
        if (IN(pb + 8)) { NEWFRAME(); peer_gather_phase(F, KA(), layer); SEAM(pb + 8); }
    }
#undef IN
#undef SEAM
#undef NEWFRAME
}

static bool phase_exists(int p) {
    if (p == 0) return true;
    const int layer = (p - 1) / 10, k = (p - 1) % 10;
    if (k == 9 || k == 5) return false;
    if ((layer & 1) && (k == 2 || k == 3)) return false;
    return true;
}
extern "C" void kernel_launch(void* const* d_in, const int* in_sizes, int n_in, void* d_out, int out_size, void* d_ws, size_t ws_size, hipStream_t stream) {
    static int grid = 0;
    if (grid == 0) {
        if (n_in != 20 || out_size != T * D || ws_size < WS_END) { fprintf(stderr, "kernel_launch: unexpected shapes (n_in %d out %d ws %zu need %zu)\n", n_in, out_size, ws_size, (size_t)WS_END); grid = -1; return; }
        int dev = 0, cus = 0;
        if (hipGetDevice(&dev) != hipSuccess || hipDeviceGetAttribute(&cus, hipDeviceAttributeMultiprocessorCount, dev) != hipSuccess) { grid = -1; return; }
        if (hipFuncSetAttribute((const void*)mk_fwd, hipFuncAttributeMaxDynamicSharedMemorySize, LDS_BYTES) != hipSuccess) { fprintf(stderr, "kernel_launch: hipFuncSetAttribute failed\n"); grid = -1; return; }
        int per_cu = 0;
        if (hipOccupancyMaxActiveBlocksPerMultiprocessor(&per_cu, (const void*)mk_fwd, NTHREADS, LDS_BYTES) != hipSuccess || per_cu < 1) { fprintf(stderr, "kernel_launch: occupancy query says %d\n", per_cu); (void)hipGetLastError(); grid = -1; return; }
        grid = cus;
    }
    if (grid < 0) return;
    (void)hipMemsetAsync((char*)d_ws + WS_CTL, 0, CTL_ZERO_BYTES, stream);
    (void)hipMemsetAsync((char*)d_ws + WS_DTACC, 0, (size_t)2 * T * NH * 4 + (size_t)2 * T * NG * 8, stream);
    Args a{};
    for (int i = 0; i < 20; ++i) a.in[i] = (const float*)d_in[i];
    a.out = (float*)d_out; a.ws = (unsigned char*)d_ws; a.pad = 0;
#if MK_MULTI
    for (int p = 0; p < NPHASE; ++p) { if (!phase_exists(p)) continue; a.ph_lo = p; a.ph_hi = p + 1; a.use_bar = 0;
        hipLaunchKernelGGL(mk_fwd, dim3(grid), dim3(NTHREADS), LDS_BYTES, stream, a); }
#else
    a.ph_lo = 0; a.ph_hi = NPHASE; a.use_bar = 1;
    hipLaunchKernelGGL(mk_fwd, dim3(grid), dim3(NTHREADS), LDS_BYTES, stream, a);
#endif
}
```
